# Optimizing an MI355X kernel written in HIP

```python
import jax, jax.numpy as jnp
from jax import lax
import numpy as np

D_MODEL = 1024
BATCH = 8
SEQ = 2048
DEPTH = 4
DEC_BATCH = 128
DEC_SEQ = 8
PAST_LEN = 16384
PAGE_SIZE = 128

N_EVEN = (DEPTH + 1) // 2
N_ODD = DEPTH // 2
BRANCH = D_MODEL // 2
W_A = BRANCH
N_HEADS_A = 8
CONV_A = 3
W_B = BRANCH
POOL_WINDOWS = (2, 4, 8, 16)
N_POOL_GROUPS = len(POOL_WINDOWS)
POOL_GROUP = W_B // N_POOL_GROUPS
POOL_HIST = max(POOL_WINDOWS) - 1
W_C = BRANCH
CHUNK = 128
N_SGU_GROUPS = 4
SGU_GROUP = W_C // N_SGU_GROUPS
W_D = BRANCH
N_HEADS_D = 8
CONV_D = 31
IN_EVEN = 4 * W_A + 2 * W_B
IN_ODD = 3 * W_C + 3 * W_D
OUT_EVEN = W_A + W_B
OUT_ODD = W_C + W_D
EPS = 1e-6

kernel_name = "hybrid_conv_pool_sgu_conformer_decode_step"


def rms_norm(x, g):
    xf = x.astype(jnp.float32)
    y = xf * lax.rsqrt(jnp.mean(xf * xf, axis=-1, keepdims=True) + EPS)
    return (y * g.astype(jnp.float32)).astype(x.dtype)


def layer_norm(x, g, b):
    xf = x.astype(jnp.float32)
    mu = jnp.mean(xf, axis=-1, keepdims=True)
    xc = xf - mu
    y = xc * lax.rsqrt(jnp.mean(xc * xc, axis=-1, keepdims=True) + EPS)
    return (y * g.astype(jnp.float32) + b.astype(jnp.float32)).astype(x.dtype)


def causal_depthwise_conv(x, hist, w):
    k = w.shape[0]
    xe = jnp.concatenate([hist.astype(x.dtype), x], axis=1)
    y = lax.conv_general_dilated(
        xe, w[:, None, :].astype(x.dtype), window_strides=(1,), padding="VALID",
        dimension_numbers=("NWC", "WIO", "NWC"), feature_group_count=x.shape[-1])
    return y, xe[:, xe.shape[1] - (k - 1):]


def short_conv_mixer(zb, zc, zh, zg, hist, conv_w):
    s = zc * zh
    y, new_hist = causal_depthwise_conv(s, hist, conv_w)
    return zb * y * jax.nn.silu(zg), new_hist


def multiscale_pool_mixer(p, zg, hist, pool_w, pool_scale, start_pos):
    bsz, t = p.shape[0], p.shape[1]
    pe = jnp.concatenate([hist.astype(p.dtype), p], axis=1)
    pf = pe.astype(jnp.float32)
    cs = jnp.concatenate([jnp.zeros((bsz, 1, W_B), jnp.float32), jnp.cumsum(pf, axis=1)], axis=1)
    pos = start_pos + jnp.arange(t, dtype=jnp.int32)
    end = POOL_HIST + 1
    means = []
    for gi, w in enumerate(POOL_WINDOWS):
        sl = slice(gi * POOL_GROUP, (gi + 1) * POOL_GROUP)
        win_sum = cs[:, end:end + t, sl] - cs[:, end - w:end - w + t, sl]
        cnt = jnp.minimum(pos + 1, w).astype(jnp.float32)[None, :, None]
        means.append(win_sum / cnt)
    d = jnp.concatenate(means, axis=-1) - pf[:, POOL_HIST:]
    d = d.reshape(bsz, t, N_POOL_GROUPS, POOL_GROUP)
    mixed = jnp.einsum("btgc,gcd->btgd", d, pool_w.astype(jnp.float32)).reshape(bsz, t, W_B)
    mixed = mixed * pool_scale.astype(jnp.float32)
    return mixed.astype(p.dtype) * jax.nn.silu(zg), pe[:, pe.shape[1] - POOL_HIST:]


def chunk_sgu_mixer(u, v, zg, ln_g, ln_b, w_s, b_s):
    bsz, t = u.shape[0], u.shape[1]
    lch = min(t, CHUNK)
    n = t // lch
    vn = layer_norm(v, ln_g, ln_b)
    vr = vn.reshape(bsz, n, lch, N_SGU_GROUPS, SGU_GROUP)
    mask = jnp.tril(jnp.ones((lch, lch), dtype=bool))
    wm = jnp.where(mask[None], w_s[:, :lch, :lch], 0.0).astype(v.dtype)
    mixed = jnp.einsum("gij,bnjgc->bnigc", wm, vr) + b_s[:, :lch].T.astype(v.dtype)[None, None, :, :, None]
    return u * mixed.reshape(bsz, t, W_C) * jax.nn.silu(zg), vn


def conformer_conv_mixer(za, zb, zg, hist, dw_w, dw_b, ln_g, ln_b):
    glu = za * jax.nn.sigmoid(zb)
    y, new_hist = causal_depthwise_conv(glu, hist, dw_w)
    y = layer_norm(y + dw_b.astype(y.dtype), ln_g, ln_b)
    return jax.nn.silu(y) * jax.nn.silu(zg), new_hist


def even_layer(x, hist_a, hist_b, start_pos, pre_g, post_g, w_in, w_out, conv_w, pool_w, pool_scale):
    h = rms_norm(x, pre_g)
    z = jnp.einsum("btd,de->bte", h, w_in)
    zb, zc, zh, ga, p, gb = jnp.split(z, 6, axis=-1)
    ya, new_a = short_conv_mixer(zb, zc, zh, ga, hist_a, conv_w)
    yb, new_b = multiscale_pool_mixer(p, gb, hist_b, pool_w, pool_scale, start_pos)
    o = jnp.einsum("bte,ed->btd", jnp.concatenate([ya, yb], axis=-1), w_out)
    return x + rms_norm(o, post_g), new_a, new_b


def odd_layer(x, hist_d, pre_g, post_g, w_in, w_out, ln_g, ln_b, w_s, b_s, dw_w, dw_b, cln_g, cln_b):
    h = rms_norm(x, pre_g)
    z = jnp.einsum("btd,de->bte", h, w_in)
    u, v, gc, za, zb, gd = jnp.split(z, 6, axis=-1)
    yc, vn = chunk_sgu_mixer(u, v, gc, ln_g, ln_b, w_s, b_s)
    yd, new_d = conformer_conv_mixer(za, zb, gd, hist_d, dw_w, dw_b, cln_g, cln_b)
    o = jnp.einsum("bte,ed->btd", jnp.concatenate([yc, yd], axis=-1), w_out)
    return x + rms_norm(o, post_g), new_d, vn


def setup_inputs(seed: int = 0) -> dict:
    key = jax.random.key(seed)
    ks = jax.random.split(key, 24)
    f32 = jnp.float32
    nrm = lambda k, shape, s: jax.random.normal(k, shape, f32) * s
    return {
        "x_prompt": nrm(ks[0], (BATCH, SEQ, D_MODEL), 1.0),
        "x_sample": nrm(ks[1], (DEC_BATCH, DEC_SEQ, D_MODEL), 1.0),
        "state_conv_a": nrm(ks[2], (N_EVEN, DEC_BATCH, CONV_A - 1, W_A), 1.0),
        "state_pool_b": nrm(ks[3], (N_EVEN, DEC_BATCH, POOL_HIST, W_B), 1.0),
        "state_conv_d": nrm(ks[4], (N_ODD, DEC_BATCH, CONV_D - 1, W_D), 1.0),
        "norm_pre": 1.0 + nrm(ks[5], (DEPTH, D_MODEL), 0.05),
        "norm_post": 1.0 + nrm(ks[6], (DEPTH, D_MODEL), 0.05),
        "w_in_even": nrm(ks[7], (N_EVEN, D_MODEL, IN_EVEN), D_MODEL ** -0.5),
        "w_out_even": nrm(ks[8], (N_EVEN, OUT_EVEN, D_MODEL), OUT_EVEN ** -0.5),
        "conv_a_w": nrm(ks[9], (N_EVEN, CONV_A, W_A), CONV_A ** -0.5),
        "pool_w": nrm(ks[10], (N_EVEN, N_POOL_GROUPS, POOL_GROUP, POOL_GROUP), POOL_GROUP ** -0.5),
        "pool_scale": 1.0 + nrm(ks[11], (N_EVEN, W_B), 0.05),
        "w_in_odd": nrm(ks[12], (N_ODD, D_MODEL, IN_ODD), D_MODEL ** -0.5),
        "w_out_odd": nrm(ks[13], (N_ODD, OUT_ODD, D_MODEL), OUT_ODD ** -0.5),
        "sgu_ln_g": 1.0 + nrm(ks[14], (N_ODD, W_C), 0.05),
        "sgu_ln_b": nrm(ks[15], (N_ODD, W_C), 0.02),
        "sgu_w": nrm(ks[16], (N_ODD, N_SGU_GROUPS, CHUNK, CHUNK), 0.02),
        "sgu_b": 1.0 + nrm(ks[17], (N_ODD, N_SGU_GROUPS, CHUNK), 0.02),
        "conf_dw_w": nrm(ks[18], (N_ODD, CONV_D, W_D), CONV_D ** -0.5),
        "conf_dw_b": nrm(ks[19], (N_ODD, W_D), 0.02),
        "conf_ln_g": 1.0 + nrm(ks[20], (N_ODD, W_D), 0.05),
        "conf_ln_b": nrm(ks[21], (N_ODD, W_D), 0.02),
    }


def reference(x_prompt, x_sample, state_conv_a, state_pool_b, state_conv_d,
              norm_pre, norm_post, w_in_even, w_out_even, conv_a_w, pool_w, pool_scale,
              w_in_odd, w_out_odd, sgu_ln_g, sgu_ln_b, sgu_w, sgu_b,
              conf_dw_w, conf_dw_b, conf_ln_g, conf_ln_b):
    xp, xs = x_prompt, x_sample
    bp = xp.shape[0]
    zero_a = jnp.zeros((bp, CONV_A - 1, W_A), xp.dtype)
    zero_b = jnp.zeros((bp, POOL_HIST, W_B), xp.dtype)
    zero_d = jnp.zeros((bp, CONV_D - 1, W_D), xp.dtype)
    ca_p, ca_s, pb_p, pb_s, cd_p, cd_s, v_s = [], [], [], [], [], [], []
    for l in range(DEPTH):
        i = l // 2
        if l % 2 == 0:
            args = (norm_pre[l], norm_post[l], w_in_even[i], w_out_even[i], conv_a_w[i], pool_w[i], pool_scale[i])
            xp, a_p, b_p = even_layer(xp, zero_a, zero_b, 0, *args)
            xs, a_s, b_s = even_layer(xs, state_conv_a[i], state_pool_b[i], PAST_LEN, *args)
            ca_p.append(a_p); ca_s.append(a_s); pb_p.append(b_p); pb_s.append(b_s)
        else:
            args = (norm_pre[l], norm_post[l], w_in_odd[i], w_out_odd[i], sgu_ln_g[i], sgu_ln_b[i],
                    sgu_w[i], sgu_b[i], conf_dw_w[i], conf_dw_b[i], conf_ln_g[i], conf_ln_b[i])
            xp, d_p, _ = odd_layer(xp, zero_d, *args)
            xs, d_s, vn_s = odd_layer(xs, state_conv_d[i], *args)
            cd_p.append(d_p); cd_s.append(d_s); v_s.append(vn_s)
    new_conv_a_prompt = jnp.stack(ca_p)
    new_conv_a_sample = jnp.stack(ca_s)
    new_pool_b_prompt = jnp.stack(pb_p)
    new_pool_b_sample = jnp.stack(pb_s)
    new_conv_d_prompt = jnp.stack(cd_p)
    new_conv_d_sample = jnp.stack(cd_s)
    new_chunk_v_sample = jnp.stack(v_s)
    return (xp, xs, new_conv_a_prompt, new_conv_a_sample, new_pool_b_prompt, new_pool_b_sample,
            new_conv_d_prompt, new_conv_d_sample, new_chunk_v_sample)
```

```cpp
#include <hip/hip_runtime.h>
#include <hip/hip_cooperative_groups.h>
#include <cstdio>
#include <cstdint>
namespace cg = cooperative_groups;

#define LAS __attribute__((address_space(3)))
typedef unsigned short bf16_t;
typedef short bf16x8 __attribute__((ext_vector_type(8)));
typedef float f32x4 __attribute__((ext_vector_type(4)));
typedef float f32x2 __attribute__((ext_vector_type(2)));
typedef unsigned u32x4 __attribute__((ext_vector_type(4)));
typedef unsigned u32x2 __attribute__((ext_vector_type(2)));

namespace pg8 {
constexpr int BM = 256, BK = 64, HALF = 128, HTB = HALF * BK * 2, STAGE_BYTES = 8 * HTB, NXCD = 8, WGM = 8;
__host__ __device__ __forceinline__ int lds_byte(int r, int c) { const int st = (r >> 4) * 2 + (c >> 5), rr = r & 15, cc = c & 31, ob = rr * 64 + cc * 2; return st * 1024 + (ob ^ (((ob >> 9) & 1) << 5)); }
__host__ __device__ __forceinline__ void stage_rc(int b, int& R, int& C) { const int st = b / 1024, sb = b % 1024, swz = sb ^ (((sb >> 9) & 1) << 5); R = (st >> 1) * 16 + swz / 64; C = (st & 1) * 32 + (swz % 64) / 2; }
__host__ __device__ __forceinline__ int perm32(int rho) { const int n = rho >> 4, i = rho & 15; return 8 * (i >> 2) + 4 * n + (i & 3); }
struct Unit { int pm, pn, koff; };
struct Gemm { const bf16_t* A; const bf16_t* Bt; int M, N, K, ld; };
struct StaticOrder {
    int nM, nN, nwg, G, c, ksb;
    __host__ __device__ void init(int M, int N, int G_, int c_, int ksb_ = 0) { nM = M / BM; nN = N / BM; nwg = nM * nN * (ksb_ ? 2 : 1); G = G_; c = c_; ksb = ksb_; }
    __host__ __device__ bool next(int i, Unit& u) const {
        const long L = (long)i * G + c; if (L >= nwg) return false;
        u.koff = 0;
        if (ksb) { const int t = (int)(L >> 1); u.koff = (int)(L & 1) * ksb; u.pm = t / nN; u.pn = t % nN; return true; }
        int wgid = (int)L; { const int q = nwg / NXCD, r = nwg % NXCD, xcd = wgid % NXCD, off = wgid / NXCD; wgid = (xcd < r ? xcd * (q + 1) : r * (q + 1) + (xcd - r) * q) + off; }
        const int nig = WGM * nN, gid = wgid / nig, fm = gid * WGM, gsz = (nM - fm) < WGM ? (nM - fm) : WGM;
        u.pm = fm + ((wgid % nig) % gsz); u.pn = (wgid % nig) / gsz; return true;
    }
    __device__ __forceinline__ void a_ready(const Unit&) const {}
    __device__ __forceinline__ void done(const Unit&) const {}
};
__device__ __forceinline__ unsigned cvt_pk_bf16(float lo, float hi) { unsigned r; asm volatile("v_cvt_pk_bf16_f32 %0, %1, %2" : "=v"(r) : "v"(lo), "v"(hi)); return r; }

__device__ __forceinline__ float ep_sig(float x) { return __builtin_amdgcn_rcpf(1.f + __expf(-x)); }
struct EpiZ {
    static constexpr bool PERM = true, AFTER_DRAIN = false;
    bf16_t* Z; int ldc; const float* rstd; float* stat; int mode; size_t kstride;
    __device__ __forceinline__ void operator()(const f32x4 (&acc)[2][2][4][2], const Unit& u, int wr, int wc, int fr, int fq) const {
        const int row0 = u.pm * BM + wr * 64 + fr;
        if (mode == 0) {
            const int col0 = u.pn * BM + wc * 32 + 8 * fq;
#pragma unroll
            for (int ai = 0; ai < 2; ++ai)
#pragma unroll
                for (int m = 0; m < 4; ++m) { const int row = row0 + ai * HALF + m * 16; const float rs = rstd ? rstd[row] : 1.f; bf16_t* rowp = Z + (u.koff ? kstride : 0) + (size_t)row * ldc + col0;
#pragma unroll
                    for (int bj = 0; bj < 2; ++bj) { const f32x4 v0 = acc[ai][bj][m][0] * rs, v1 = acc[ai][bj][m][1] * rs;
                        u32x4 w; w.x = cvt_pk_bf16(v0[0], v0[1]); w.y = cvt_pk_bf16(v0[2], v0[3]); w.z = cvt_pk_bf16(v1[0], v1[1]); w.w = cvt_pk_bf16(v1[2], v1[3]);
                        *(u32x4*)(rowp + bj * HALF) = w; } }
            return;
        }
        const int q = u.pn >> 2, cb = (u.pn & 3) * 128 + wc * 32 + 8 * fq;
        const int op = mode == 1 ? q : (q == 0 ? 1 : (q == 1 ? 3 : 2));
        const int oc = mode == 1 ? q * 512 : (q == 0 ? 0 : (q == 1 ? 1024 : 512));
#pragma unroll
        for (int ai = 0; ai < 2; ++ai)
#pragma unroll
            for (int m = 0; m < 4; ++m) { const int row = row0 + ai * HALF + m * 16; const float rs = rstd[row]; bf16_t* rowp = Z + (size_t)row * ldc + cb;
                float x[8], y[8], r[8];
#pragma unroll
                for (int e = 0; e < 4; ++e) { x[e] = acc[ai][0][m][0][e] * rs; x[4 + e] = acc[ai][0][m][1][e] * rs; y[e] = acc[ai][1][m][0][e] * rs; y[4 + e] = acc[ai][1][m][1][e] * rs; }
                if (op == 0) {
#pragma unroll
                    for (int e = 0; e < 8; ++e) r[e] = x[e] * y[e]; }
                else if (op == 1) {
#pragma unroll
                    for (int e = 0; e < 8; ++e) r[e] = x[e] * y[e] * ep_sig(y[e]); }
                else if (op == 3) {
#pragma unroll
                    for (int e = 0; e < 8; ++e) r[e] = x[e] * ep_sig(y[e]); }
                else {
#pragma unroll
                    for (int e = 0; e < 8; ++e) r[e] = x[e];
                    u32x4 w2; w2.x = cvt_pk_bf16(y[0] * ep_sig(y[0]), y[1] * ep_sig(y[1])); w2.y = cvt_pk_bf16(y[2] * ep_sig(y[2]), y[3] * ep_sig(y[3]));
                    w2.z = cvt_pk_bf16(y[4] * ep_sig(y[4]), y[5] * ep_sig(y[5])); w2.w = cvt_pk_bf16(y[6] * ep_sig(y[6]), y[7] * ep_sig(y[7]));
                    *(u32x4*)(rowp + 1536) = w2;
                    if (stat) { float sm = ((x[0] + x[1]) + (x[2] + x[3])) + ((x[4] + x[5]) + (x[6] + x[7]));
                        float sq = ((x[0] * x[0] + x[1] * x[1]) + (x[2] * x[2] + x[3] * x[3])) + ((x[4] * x[4] + x[5] * x[5]) + (x[6] * x[6] + x[7] * x[7]));
                        sm += __shfl_xor(sm, 16); sm += __shfl_xor(sm, 32); sq += __shfl_xor(sq, 16); sq += __shfl_xor(sq, 32);
                        if (fq == 0) { __hip_atomic_fetch_add(stat + 2 * row, sm, __ATOMIC_RELAXED, __HIP_MEMORY_SCOPE_AGENT); __hip_atomic_fetch_add(stat + 2 * row + 1, sq, __ATOMIC_RELAXED, __HIP_MEMORY_SCOPE_AGENT); } } }
                u32x4 w; w.x = cvt_pk_bf16(r[0], r[1]); w.y = cvt_pk_bf16(r[2], r[3]); w.z = cvt_pk_bf16(r[4], r[5]); w.w = cvt_pk_bf16(r[6], r[7]);
                *(u32x4*)(rowp + oc) = w; }
    }
};

template <class Epi, class Sched, bool ALIGN_EPI = false, bool SP2 = false>
__device__ __forceinline__ void gemm_phase(LAS unsigned char* lds, const Gemm g, const Sched& S, const Epi& E) {
    int tid_ = threadIdx.x; asm volatile("" : "+v"(tid_));
    const int tid = tid_, wid = __builtin_amdgcn_readfirstlane(tid >> 6), lane = tid & 63, wr = wid >> 2, wc = wid & 3, fr = lane & 15, fq = lane >> 4;
    const int K = g.ld, nt = g.K / BK;
    unsigned voffA[2], voffB[2];
#pragma unroll
    for (int i = 0; i < 2; ++i) { int R, C; stage_rc(tid * 16 + i * 8192, R, C); const int Rb = Epi::PERM ? ((R & ~31) + perm32(R & 31)) : R;
        voffA[i] = (unsigned)(R * K + C) * 2u; voffB[i] = (unsigned)(Rb * K + C) * 2u; }
    const size_t kstep = (size_t)(BK * 2);
    const size_t hstep = (size_t)HALF * K * 2;
    const size_t tstep = 2 * hstep;
    const unsigned ldsw = (unsigned)wid * 1024u;
    const int aoff = lds_byte(wr * 64 + fr, fq * 8), boff = lds_byte(wc * 32 + fr, fq * 8);
#define PG8_SA(b, h) (((b) * 2 + (h)) * HTB)
#define PG8_SB(b, h) ((4 + (b) * 2 + (h)) * HTB)
#define PG8_STAGE(bufoff, gbase, voff) do { _Pragma("unroll") for (int _i = 0; _i < 2; ++_i) \
        __builtin_amdgcn_global_load_lds((const unsigned*)((const char*)(gbase) + (voff)[_i]), (LAS unsigned*)(lds + (bufoff) + ldsw + _i * 8192), 16, 0, 0); } while (0)
#define PG8_LDA(dst, b, h) do { _Pragma("unroll") for (int m = 0; m < 4; ++m) _Pragma("unroll") for (int k = 0; k < 2; ++k) dst[m][k] = *(const LAS bf16x8*)(lds + PG8_SA(b, h) + aoff + m * 2048 + k * 1024); } while (0)
#define PG8_LDB(dst, b, h) do { _Pragma("unroll") for (int n = 0; n < 2; ++n) _Pragma("unroll") for (int k = 0; k < 2; ++k) dst[n][k] = *(const LAS bf16x8*)(lds + PG8_SB(b, h) + boff + n * 2048 + k * 1024); } while (0)
#define PG8_MMA(ai, bj, At, Bt) do { __builtin_amdgcn_s_setprio(1); _Pragma("unroll") for (int m = 0; m < 4; ++m) _Pragma("unroll") for (int n = 0; n < 2; ++n) _Pragma("unroll") for (int k = 0; k < 2; ++k) \
        acc[ai][bj][m][n] = __builtin_amdgcn_mfma_f32_16x16x32_bf16(Bt[n][k], At[m][k], acc[ai][bj][m][n], 0, 0, 0); __builtin_amdgcn_s_setprio(0); } while (0)
#define PG8_WAIT_V(n) asm volatile("s_waitcnt vmcnt(" #n ")" ::: "memory")
#define PG8_WAIT_L(n) asm volatile("s_waitcnt lgkmcnt(" #n ")" ::: "memory")
#define PG8_BAR __builtin_amdgcn_s_barrier()
#define PG8_SCHED __builtin_amdgcn_sched_barrier(0)
    Unit cur, nxt; int ui = 0;
    if (!S.next(0, cur)) return;
    f32x4 acc[2][2][4][2];
#pragma unroll
    for (int a = 0; a < 2; ++a)
#pragma unroll
        for (int b = 0; b < 2; ++b)
#pragma unroll
            for (int m = 0; m < 4; ++m)
#pragma unroll
                for (int n = 0; n < 2; ++n) acc[a][b][m][n] = (f32x4){0.f, 0.f, 0.f, 0.f};
    bf16x8 At[4][2], B0[2][2], B1[2][2];
    const char* cA = (const char*)g.A + (size_t)cur.pm * tstep + cur.koff; const char* cB = (const char*)g.Bt + (size_t)cur.pn * tstep + cur.koff;
    S.a_ready(cur);
    if constexpr (SP2) {
        PG8_STAGE(PG8_SB(0, 0), cB, voffB); PG8_STAGE(PG8_SB(0, 1), cB + hstep, voffB); PG8_STAGE(PG8_SA(0, 0), cA, voffA); PG8_STAGE(PG8_SA(0, 1), cA + hstep, voffA);
        if (wr == 1) PG8_BAR;
        PG8_WAIT_V(2); PG8_BAR;
        PG8_STAGE(PG8_SB(1, 0), cB + kstep, voffB); PG8_STAGE(PG8_SA(1, 0), cA + kstep, voffA); PG8_STAGE(PG8_SB(1, 1), cB + hstep + kstep, voffB);
        PG8_WAIT_V(6); PG8_BAR;
    } else {
        PG8_STAGE(PG8_SB(0, 0), cB, voffB); PG8_STAGE(PG8_SA(0, 0), cA, voffA); PG8_STAGE(PG8_SB(0, 1), cB + hstep, voffB); PG8_STAGE(PG8_SA(0, 1), cA + hstep, voffA);
        if (wr == 1) PG8_BAR;
        PG8_WAIT_V(4); PG8_BAR;
        PG8_STAGE(PG8_SB(1, 0), cB + kstep, voffB); PG8_STAGE(PG8_SA(1, 0), cA + kstep, voffA); PG8_STAGE(PG8_SB(1, 1), cB + hstep + kstep, voffB);
        PG8_WAIT_V(6); PG8_BAR;
    }
    for (;;) {
        const bool has_next = S.next(ui + 1, nxt);
        const char* nA = has_next ? (const char*)g.A + (size_t)nxt.pm * tstep + nxt.koff : cA; const char* nB = has_next ? (const char*)g.Bt + (size_t)nxt.pn * tstep + nxt.koff : cB;
        for (int t = 0; t < nt; t += 2) {
            const bool last = (t == nt - 2);
            const char* a1 = cA + (size_t)(t + 1) * kstep;
            const char* a2 = last ? nA : cA + (size_t)(t + 2) * kstep; const char* b2 = last ? nB : cB + (size_t)(t + 2) * kstep;
            const char* a3 = a2 + kstep; const char* b3 = b2 + kstep;
            if (last && has_next) S.a_ready(nxt);
            if constexpr (SP2) {
            PG8_LDB(B0, 0, 0); PG8_LDB(B1, 0, 1); PG8_SCHED; PG8_LDA(At, 0, 0); PG8_STAGE(PG8_SA(1, 1), a1 + hstep, voffA);
            PG8_WAIT_V(8); PG8_WAIT_L(0); PG8_BAR; PG8_MMA(0, 0, At, B0); PG8_MMA(0, 1, At, B1); PG8_BAR; PG8_SCHED;
            PG8_LDA(At, 0, 1); PG8_STAGE(PG8_SB(0, 0), b2, voffB); PG8_STAGE(PG8_SB(0, 1), b2 + hstep, voffB); PG8_STAGE(PG8_SA(0, 0), a2, voffA);
            PG8_WAIT_V(8); PG8_WAIT_L(0); PG8_BAR; PG8_MMA(1, 0, At, B0); PG8_MMA(1, 1, At, B1); PG8_BAR; PG8_SCHED;
            PG8_LDB(B0, 1, 0); PG8_LDB(B1, 1, 1); PG8_SCHED; PG8_LDA(At, 1, 0); PG8_STAGE(PG8_SA(0, 1), a2 + hstep, voffA);
            PG8_WAIT_V(8); PG8_WAIT_L(0); PG8_BAR; PG8_MMA(0, 0, At, B0); PG8_MMA(0, 1, At, B1); PG8_BAR; PG8_SCHED;
            PG8_LDA(At, 1, 1); PG8_STAGE(PG8_SB(1, 0), b3, voffB); PG8_STAGE(PG8_SB(1, 1), b3 + hstep, voffB); PG8_STAGE(PG8_SA(1, 0), a3, voffA);
            PG8_WAIT_V(8); PG8_WAIT_L(0); PG8_BAR; PG8_MMA(1, 0, At, B0); PG8_MMA(1, 1, At, B1); PG8_BAR; PG8_SCHED;
            } else {
            PG8_LDB(B0, 0, 0); PG8_SCHED; PG8_LDA(At, 0, 0); PG8_STAGE(PG8_SA(1, 1), a1 + hstep, voffA);
            PG8_WAIT_L(8); PG8_BAR; PG8_WAIT_L(0); PG8_MMA(0, 0, At, B0); PG8_BAR; PG8_SCHED;
            PG8_LDB(B1, 0, 1); PG8_STAGE(PG8_SB(0, 0), b2, voffB);
            PG8_BAR; PG8_WAIT_L(0); PG8_MMA(0, 1, At, B1); PG8_BAR;
            PG8_LDA(At, 0, 1); PG8_STAGE(PG8_SA(0, 0), a2, voffA);
            PG8_BAR; PG8_WAIT_L(0); PG8_MMA(1, 0, At, B0); PG8_BAR; PG8_SCHED;
            PG8_STAGE(PG8_SB(0, 1), b2 + hstep, voffB);
            PG8_WAIT_V(6); PG8_BAR; PG8_MMA(1, 1, At, B1); PG8_BAR;
            PG8_LDB(B0, 1, 0); PG8_SCHED; PG8_LDA(At, 1, 0); PG8_STAGE(PG8_SA(0, 1), a2 + hstep, voffA);
            PG8_WAIT_L(8); PG8_BAR; PG8_WAIT_L(0); PG8_MMA(0, 0, At, B0); PG8_BAR; PG8_SCHED;
            PG8_LDB(B1, 1, 1); PG8_STAGE(PG8_SB(1, 0), b3, voffB);
            PG8_BAR; PG8_WAIT_L(0); PG8_MMA(0, 1, At, B1); PG8_BAR;
            PG8_LDA(At, 1, 1); PG8_STAGE(PG8_SA(1, 0), a3, voffA);
            PG8_BAR; PG8_WAIT_L(0); PG8_MMA(1, 0, At, B0); PG8_BAR; PG8_SCHED;
            PG8_STAGE(PG8_SB(1, 1), b3 + hstep, voffB);
            PG8_WAIT_V(6); PG8_BAR; PG8_MMA(1, 1, At, B1); PG8_BAR;
            }
        }
        if constexpr (ALIGN_EPI) { if (wr == 0) PG8_BAR; }
        if constexpr (!Epi::AFTER_DRAIN) { E(acc, cur, wr, wc, fr, fq); S.done(cur); }
        if (!has_next) break;
#pragma unroll
        for (int a = 0; a < 2; ++a)
#pragma unroll
            for (int b = 0; b < 2; ++b)
#pragma unroll
                for (int m = 0; m < 4; ++m)
#pragma unroll
                    for (int n = 0; n < 2; ++n) acc[a][b][m][n] = (f32x4){0.f, 0.f, 0.f, 0.f};
        cur = nxt; cA = nA; cB = nB; ++ui;
        if constexpr (ALIGN_EPI) { if (wr == 1) PG8_BAR; }
    }
    PG8_WAIT_V(0);
    if constexpr (!ALIGN_EPI) { if (wr == 0) PG8_BAR; }
    PG8_BAR;
#undef PG8_SA
#undef PG8_SB
#undef PG8_STAGE
#undef PG8_LDA
#undef PG8_LDB
#undef PG8_MMA
#undef PG8_WAIT_V
#undef PG8_WAIT_L
#undef PG8_BAR
#undef PG8_SCHED
}
}

constexpr int D = 1024, MP = 16384, MS = 1024, M = MP + MS, NIN = 3072, BR = 512, SEQ = 2048, DSEQ = 8, NSB = 128;
constexpr int NZ = 2048;
constexpr float EPS = 1e-6f;
constexpr int NWAVES = 8, NT = 512;
constexpr size_t O_Y = 0;
constexpr size_t O_CAP = (size_t)M * D;
constexpr size_t O_CAS = O_CAP + 2 * 8 * 2 * 512;
constexpr size_t O_PBP = O_CAS + 2 * 128 * 2 * 512;
constexpr size_t O_PBS = O_PBP + 2 * 8 * 15 * 512;
constexpr size_t O_CDP = O_PBS + 2 * 128 * 15 * 512;
constexpr size_t O_CDS = O_CDP + 2 * 8 * 30 * 512;
constexpr size_t O_CV = O_CDS + 2 * 128 * 30 * 512;
constexpr size_t O_END = O_CV + 2 * 128 * 8 * 512;
constexpr size_t MiB = 1u << 20;
constexpr size_t WS_STAT = 65536;
constexpr size_t WS_ZERO_BYTES = WS_STAT + 2 * (size_t)17408 * 2 * 4;
constexpr size_t WS_WIN = 1 * MiB;
constexpr size_t WS_WOUT = 25 * MiB;
constexpr size_t WS_PWT = 33 * MiB;
constexpr size_t WS_SGW = 33 * MiB + 256 * 1024;
constexpr size_t WS_RSTD = 33 * MiB + 512 * 1024;
constexpr size_t WS_XB = 34 * MiB;
constexpr size_t WS_Z = 68 * MiB;
constexpr size_t WS_Y = 170 * MiB;
constexpr size_t WS_OS = 204 * MiB;
constexpr size_t WS_END = 208 * MiB;
constexpr int LDS_BYTES = 147456;

struct Params {
    const float* xp; const float* xs; const float* st_a; const float* st_b; const float* st_d;
    const float* norm_pre; const float* norm_post; const float* w_in_even; const float* w_out_even;
    const float* conv_a_w; const float* pool_w; const float* pool_scale;
    const float* w_in_odd; const float* w_out_odd; const float* sgu_ln_g; const float* sgu_ln_b;
    const float* sgu_w; const float* sgu_b; const float* dw_w; const float* dw_b; const float* cln_g; const float* cln_b;
    float* out; unsigned char* ws; int ph_lo, ph_hi;
};

__device__ __forceinline__ unsigned pk2(float lo, float hi) { unsigned r; asm("v_cvt_pk_bf16_f32 %0, %1, %2" : "=v"(r) : "v"(lo), "v"(hi)); return r; }
__device__ __forceinline__ unsigned f2bf(float f) { return pk2(f, 0.f) & 0xffffu; }
__device__ __forceinline__ float bf2f(unsigned short b) { return __uint_as_float((unsigned)b << 16); }
__device__ __forceinline__ void unpack8(const u32x4 v, float (&f)[8]) {
#pragma unroll
    for (int i = 0; i < 4; ++i) { f[2 * i] = __uint_as_float(v[i] << 16); f[2 * i + 1] = __uint_as_float(v[i] & 0xffff0000u); }
}
__device__ __forceinline__ u32x4 pack8(const float (&f)[8]) { u32x4 w; w.x = pk2(f[0], f[1]); w.y = pk2(f[2], f[3]); w.z = pk2(f[4], f[5]); w.w = pk2(f[6], f[7]); return w; }
__device__ __forceinline__ void unpack4(const u32x2 v, float (&f)[4]) { f[0] = __uint_as_float(v.x << 16); f[1] = __uint_as_float(v.x & 0xffff0000u); f[2] = __uint_as_float(v.y << 16); f[3] = __uint_as_float(v.y & 0xffff0000u); }
__device__ __forceinline__ float sigmoidf_(float x) { return __builtin_amdgcn_rcpf(1.f + __expf(-x)); }
__device__ __forceinline__ float siluf_(float x) { return x * sigmoidf_(x); }
__device__ __forceinline__ float wave_sum(float v) {
#pragma unroll
    for (int o = 1; o < 64; o <<= 1) v += __shfl_xor(v, o);
    return v;
}
__device__ __forceinline__ const float* xin_row(const Params& p, int l, int m) {
    return m < MP ? p.xp + (size_t)m * D : p.xs + (size_t)(m - MP) * D;
}

__device__ __forceinline__ int perm_col(int n0, int pmode) {
    if (pmode == 0) return n0;
    const int sidx = n0 >> 9, c0 = n0 & 511, tb = ((pmode == 1 ? 0x884004 : 0x844080) >> (4 * sidx)) & 15, hf = ((pmode == 1 ? 0x2C : 0x34) >> sidx) & 1;
    return (tb + (c0 >> 7)) * 256 + hf * 128 + (c0 & 127);
}
__device__ __forceinline__ void transpose_item(const float* W, const float* gs, int K, int N, bf16_t* WT, LAS float* scr, int item, int lane, int pmode) {
    const int nblk = N / 32, kb = item / nblk, nb = item % nblk, k0 = 64 * kb, n0 = 32 * nb, nd0 = perm_col(n0, pmode);
    { const int r8 = lane >> 3, c4 = lane & 7; f32x4 v[8]; float sc[8];
#pragma unroll
      for (int i = 0; i < 8; ++i) { const int kk = 8 * i + r8; v[i] = *(const f32x4*)(W + (size_t)(k0 + kk) * N + n0 + 4 * c4); sc[i] = gs ? gs[k0 + kk] : 1.f; }
#pragma unroll
      for (int i = 0; i < 8; ++i) { LAS float* d = scr + (8 * i + r8) * 33 + 4 * c4; d[0] = v[i].x * sc[i]; d[1] = v[i].y * sc[i]; d[2] = v[i].z * sc[i]; d[3] = v[i].w * sc[i]; } }
    asm volatile("s_waitcnt lgkmcnt(0)" ::: "memory");
    const int c = lane & 7;
#pragma unroll
    for (int j = 0; j < 4; ++j) { const int n = (lane >> 3) + 8 * j; const LAS float* s = scr + (8 * c) * 33 + n;
        u32x4 o; o.x = pk2(s[0 * 33], s[1 * 33]); o.y = pk2(s[2 * 33], s[3 * 33]); o.z = pk2(s[4 * 33], s[5 * 33]); o.w = pk2(s[6 * 33], s[7 * 33]);
        *(u32x4*)(WT + (size_t)(nd0 + n) * K + k0 + 8 * c) = o; }
    asm volatile("s_waitcnt lgkmcnt(0)" ::: "memory");
}
__device__ __forceinline__ void weights_phase(const Params& p, LAS unsigned char* lds, int l, int bfirst) {
    int tid_ = threadIdx.x; asm volatile("" : "+v"(tid_));
    const int tid = tid_, lane = tid & 63, wave = tid >> 6;
    if ((int)blockIdx.x < bfirst) return;
    const int gw = ((int)blockIdx.x - bfirst) * NWAVES + wave, NGW = ((int)gridDim.x - bfirst) * NWAVES;
    LAS float* scr = (LAS float*)(lds + wave * 16384);
    bf16_t* wtin = (bf16_t*)(p.ws + WS_WIN) + (size_t)l * NIN * D; bf16_t* wtout = (bf16_t*)(p.ws + WS_WOUT) + (size_t)l * D * D;
    constexpr int I_IN = (D / 64) * (NIN / 32), I_OUT = (D / 64) * (D / 32);
    const float* Wi = ((l & 1) ? p.w_in_odd : p.w_in_even) + (size_t)(l >> 1) * D * NIN; const float* Wo = ((l & 1) ? p.w_out_odd : p.w_out_even) + (size_t)(l >> 1) * D * D;
    for (int it = gw; it < I_IN + I_OUT; it += NGW) {
        if (it < I_IN) transpose_item(Wi, p.norm_pre + l * D, D, NIN, wtin, scr, it, lane, (l & 1) ? 2 : 1);
        else transpose_item(Wo, nullptr, D, D, wtout, scr, it - I_IN, lane, 0);
    }
}
__device__ __forceinline__ void prologue(const Params& p, LAS unsigned char* lds) {
    int tid_ = threadIdx.x; asm volatile("" : "+v"(tid_));
    const int tid = tid_, lane = tid & 63, wave = tid >> 6;
    const int gw = blockIdx.x * NWAVES + wave, NGW = gridDim.x * NWAVES;
    const int gt = blockIdx.x * NT + tid, NGT = gridDim.x * NT;
    bf16_t* pwt = (bf16_t*)(p.ws + WS_PWT); bf16_t* sgw = (bf16_t*)(p.ws + WS_SGW);
    for (int e = gt; e < 2 * 4 * 128 * 128; e += NGT) {
        const int c = e & 127, d = (e >> 7) & 127, lg = e >> 14, g = lg & 3, li = lg >> 2;
        pwt[e] = (bf16_t)f2bf(p.pool_w[((size_t)lg * 128 + c) * 128 + d] * p.pool_scale[li * BR + g * 128 + d]);
        const int j = e & 127, i = (e >> 7) & 127;
        sgw[e] = (bf16_t)f2bf(j <= i ? p.sgu_w[e] : 0.f);
    }
    {
        constexpr int N1 = 2 * NSB * 7 * (BR / 4), N2 = 2 * NSB * 22 * (BR / 4);
        for (int e0 = gt; e0 < N1 + N2; e0 += 4 * NGT) {
            f32x4 v[4]; float* dst[4];
#pragma unroll
            for (int u = 0; u < 4; ++u) { const int e = e0 + u * NGT; dst[u] = nullptr; v[u] = (f32x4){0.f, 0.f, 0.f, 0.f};
                if (e < N1) { const int c4 = e & 127, rr = e >> 7, r = rr % 7, lb = rr / 7;
                    v[u] = *(const f32x4*)(p.st_b + ((size_t)lb * 15 + 8 + r) * BR + c4 * 4); dst[u] = p.out + O_PBS + ((size_t)lb * 15 + r) * BR + c4 * 4; }
                else if (e < N1 + N2) { const int f = e - N1, c4 = f & 127, rr = f >> 7, r = rr % 22, lb = rr / 22;
                    v[u] = *(const f32x4*)(p.st_d + ((size_t)lb * 30 + 8 + r) * BR + c4 * 4); dst[u] = p.out + O_CDS + ((size_t)lb * 30 + r) * BR + c4 * 4; } }
#pragma unroll
            for (int u = 0; u < 4; ++u) if (dst[u]) *(f32x4*)dst[u] = v[u];
        }
    }
    for (int e = gt; e < (int)((WS_ZERO_BYTES - WS_STAT) / 16); e += NGT) *(f32x4*)(p.ws + WS_STAT + (size_t)e * 16) = (f32x4){0.f, 0.f, 0.f, 0.f};
    bf16_t* xb = (bf16_t*)(p.ws + WS_XB); float* rstd = (float*)(p.ws + WS_RSTD);
    for (int mb = gw; mb < M; mb += 2 * NGW) {
        f32x4 v[2][4];
#pragma unroll
        for (int r = 0; r < 2; ++r) { const int m = mb + r * NGW; const bool ok = m < M; const float* xr = xin_row(p, 0, ok ? m : mb) + lane * 8;
#pragma unroll
            for (int j = 0; j < 2; ++j) { v[r][2 * j] = ok ? *(const f32x4*)(xr + 512 * j) : (f32x4){0.f, 0.f, 0.f, 0.f}; v[r][2 * j + 1] = ok ? *(const f32x4*)(xr + 512 * j + 4) : (f32x4){0.f, 0.f, 0.f, 0.f}; } }
#pragma unroll
        for (int r = 0; r < 2; ++r) { const int m = mb + r * NGW; float s = 0.f;
#pragma unroll
            for (int j = 0; j < 4; ++j) s += (v[r][j].x * v[r][j].x + v[r][j].y * v[r][j].y) + (v[r][j].z * v[r][j].z + v[r][j].w * v[r][j].w);
            s = wave_sum(s);
            if (m < M) { if (lane == 0) rstd[m] = rsqrtf(s * (1.f / D) + EPS);
#pragma unroll
                for (int j = 0; j < 2; ++j) { u32x4 w; w.x = pk2(v[r][2 * j].x, v[r][2 * j].y); w.y = pk2(v[r][2 * j].z, v[r][2 * j].w); w.z = pk2(v[r][2 * j + 1].x, v[r][2 * j + 1].y); w.w = pk2(v[r][2 * j + 1].z, v[r][2 * j + 1].w);
                    *(u32x4*)(xb + (size_t)m * D + lane * 8 + 512 * j) = w; } } }
    }
}

__device__ __forceinline__ const bf16_t* o_row(const Params& p, int m) { return m < MP ? (const bf16_t*)(p.ws + WS_Z) + (size_t)m * D : (const bf16_t*)(p.ws + WS_OS) + (size_t)(m - MP) * D; }
__device__ __forceinline__ void post_phase(const Params& p, int l, int row_lo, int row_hi, int bfirst) {
    int tid_ = threadIdx.x; asm volatile("" : "+v"(tid_));
    const int tid = tid_, lane = tid & 63, wave = tid >> 6;
    if ((int)blockIdx.x < bfirst) return;
    const int gw = ((int)blockIdx.x - bfirst) * NWAVES + wave, NGW = ((int)gridDim.x - bfirst) * NWAVES;
    bf16_t* xb = (bf16_t*)(p.ws + WS_XB); float* rstd = (float*)(p.ws + WS_RSTD);
    float g[16];
#pragma unroll
    for (int j = 0; j < 2; ++j) { const f32x4 a = *(const f32x4*)(p.norm_post + l * D + lane * 8 + 512 * j), b = *(const f32x4*)(p.norm_post + l * D + lane * 8 + 512 * j + 4);
        g[8 * j] = a.x; g[8 * j + 1] = a.y; g[8 * j + 2] = a.z; g[8 * j + 3] = a.w; g[8 * j + 4] = b.x; g[8 * j + 5] = b.y; g[8 * j + 6] = b.z; g[8 * j + 7] = b.w; }
    constexpr int RPI = 4;
    for (int mb = row_lo + gw; mb < row_hi; mb += RPI * NGW) {
        const bool two = row_lo >= MP;
        u32x4 orw[RPI][2], xrw[RPI][2], o2w[RPI][2];
#pragma unroll
        for (int r = 0; r < RPI; ++r) { const int m = mb + r * NGW; const bool ok = m < row_hi;
#pragma unroll
            for (int j = 0; j < 2; ++j) { const u32x4 z4 = (u32x4){0u, 0u, 0u, 0u};
                orw[r][j] = ok ? *(const u32x4*)(o_row(p, m) + lane * 8 + 512 * j) : z4; xrw[r][j] = ok ? *(const u32x4*)(xb + (size_t)m * D + lane * 8 + 512 * j) : z4;
                o2w[r][j] = (ok && two) ? *(const u32x4*)(o_row(p, m) + (size_t)MS * D + lane * 8 + 512 * j) : z4; } }
#pragma unroll
        for (int r = 0; r < RPI; ++r) { const int m = mb + r * NGW;
            float o[16], x[16]; float ss = 0.f;
#pragma unroll
            for (int j = 0; j < 2; ++j) { float t8[8], u8[8]; unpack8(orw[r][j], t8); unpack8(o2w[r][j], u8);
#pragma unroll
                for (int e = 0; e < 8; ++e) { t8[e] += u8[e]; o[8 * j + e] = t8[e]; ss += t8[e] * t8[e]; }
                unpack8(xrw[r][j], t8);
#pragma unroll
                for (int e = 0; e < 8; ++e) x[8 * j + e] = t8[e]; }
            const float rs = rsqrtf(wave_sum(ss) * (1.f / D) + EPS); float s2 = 0.f;
#pragma unroll
            for (int e = 0; e < 16; ++e) { x[e] += o[e] * rs * g[e]; s2 += x[e] * x[e]; }
            if (l < 3) s2 = wave_sum(s2);
            if (m < row_hi) {
                if (l < 3) {
#pragma unroll
                for (int j = 0; j < 2; ++j) { u32x4 w; w.x = pk2(x[8 * j], x[8 * j + 1]); w.y = pk2(x[8 * j + 2], x[8 * j + 3]); w.z = pk2(x[8 * j + 4], x[8 * j + 5]); w.w = pk2(x[8 * j + 6], x[8 * j + 7]);
                    *(u32x4*)(xb + (size_t)m * D + lane * 8 + 512 * j) = w; }
                if (lane == 0) rstd[m] = rsqrtf(s2 * (1.f / D) + EPS); }
                else {
#pragma unroll
                    for (int j = 0; j < 2; ++j) { float* orow = p.out + (size_t)m * D + lane * 8 + 512 * j;
                        *(f32x4*)orow = (f32x4){x[8 * j], x[8 * j + 1], x[8 * j + 2], x[8 * j + 3]}; *(f32x4*)(orow + 4) = (f32x4){x[8 * j + 4], x[8 * j + 5], x[8 * j + 6], x[8 * j + 7]}; } }
            }
        }
    }
}

struct ItemFeed {
    unsigned* ctr; volatile LAS int* slot; int n, k, cur, nxt, stride;
    __device__ __forceinline__ void init(unsigned* c, volatile LAS int* s, int nItems, int bfirst) {
        ctr = c; slot = s; n = nItems; k = 0; stride = (int)gridDim.x - bfirst;
        if (ctr) { if (threadIdx.x == 0) { slot[0] = (int)__hip_atomic_fetch_add(ctr, 1u, __ATOMIC_RELAXED, __HIP_MEMORY_SCOPE_AGENT); } __syncthreads(); cur = slot[0]; }
        else { cur = (int)blockIdx.x - bfirst; if (cur < 0) cur = n; }
    }
    __device__ __forceinline__ bool have() const { return cur < n; }
    __device__ __forceinline__ void prefetch() { if (ctr && threadIdx.x == 0) nxt = (int)__hip_atomic_fetch_add(ctr, 1u, __ATOMIC_RELAXED, __HIP_MEMORY_SCOPE_AGENT); }
    __device__ __forceinline__ void advance() {
        if (ctr) { ++k; if (threadIdx.x == 0) slot[k & 1] = nxt; __syncthreads(); cur = slot[k & 1]; }
        else cur += stride;
    }
};

constexpr int LDP = 136;
template <int W>
__device__ __forceinline__ void pool_d_tile(const Params& p, int li, int g, int m0, bool samp, int tid, LAS bf16_t* dT) {
    const bf16_t* Z = (const bf16_t*)(p.ws + WS_Z);
    if (!samp) {
        constexpr int RPT = (W >= 16) ? 2 : 4, NL = W + RPT - 1;
#pragma unroll 1
        for (int bt = 0; bt < 4 / RPT; ++bt) {
        const int rseg = bt * 32 + (tid >> 4), pc = tid & 15, ch = g * 128 + pc * 8, mtop = m0 + RPT * rseg + RPT - 1, ttop = mtop & (SEQ - 1);
        const bf16_t* zp = Z + (size_t)mtop * NZ + 1024 + ch;
        u32x4 raw[NL];
#pragma unroll
        for (int i = 0; i < NL; ++i) raw[i] = *(const u32x4*)(zp - (size_t)((ttop - i >= 0) ? i : 0) * NZ);
        float sum[RPT][8];
        const bool first = (m0 & (SEQ - 1)) == 0;
#pragma unroll
        for (int e = 0; e < 8; ++e) sum[0][e] = 0.f;
#pragma unroll
        for (int i = RPT - 1; i < RPT - 1 + W; ++i) { float a[8]; unpack8(raw[i], a);
            if (first) { const float mk = (ttop - i >= 0) ? 1.f : 0.f;
#pragma unroll
                for (int e = 0; e < 8; ++e) a[e] *= mk; }
#pragma unroll
            for (int e = 0; e < 8; ++e) sum[0][e] += a[e]; }
#pragma unroll
        for (int q = 1; q < RPT; ++q) { float a[8], b[8]; unpack8(raw[RPT - 1 - q], a); unpack8(raw[RPT - 1 - q + W], b);
            if (first) { const float mb_ = (ttop - (RPT - 1 - q + W) >= 0) ? 1.f : 0.f;
#pragma unroll
                for (int e = 0; e < 8; ++e) b[e] *= mb_; }
#pragma unroll
            for (int e = 0; e < 8; ++e) sum[q][e] = sum[q - 1][e] + a[e] - b[e]; }
#pragma unroll
        for (int q = 0; q < RPT; ++q) { const int t = ttop - (RPT - 1) + q, m = mtop - (RPT - 1) + q; float pv[8], dv[8]; unpack8(raw[RPT - 1 - q], pv);
            const float ic = 1.f / (float)(t + 1 < W ? t + 1 : W);
#pragma unroll
            for (int e = 0; e < 8; ++e) dv[e] = sum[q][e] * ic - pv[e];
            *(LAS u32x4*)(dT + (RPT * rseg + q) * LDP + pc * 8) = pack8(dv);
            if (t >= SEQ - 15) { float* so = p.out + O_PBP + ((size_t)(li * 8 + (m >> 11)) * 15 + (t - (SEQ - 15))) * BR + ch;
                *(f32x4*)so = (f32x4){pv[0], pv[1], pv[2], pv[3]}; *(f32x4*)(so + 4) = (f32x4){pv[4], pv[5], pv[6], pv[7]}; } }
        }
        return;
    }
    LAS bf16_t* pe = dT + 128 * LDP;
    const int bseq0 = (m0 - MP) >> 3;
    { u32x4 zr[4]; f32x4 h0[8], h1[8];
#pragma unroll
      for (int k = 0; k < 4; ++k) { const int idx = tid + NT * k, row = idx >> 4, pc = idx & 15; zr[k] = *(const u32x4*)(Z + (size_t)(m0 + row) * NZ + 1024 + g * 128 + pc * 8); }
#pragma unroll
      for (int k = 0; k < 8; ++k) { const int idx = tid + NT * k, pc = idx & 15, sr = idx >> 4, seq = sr / 15, hr = sr - seq * 15;
          h0[k] = (f32x4){0.f, 0.f, 0.f, 0.f}; h1[k] = h0[k];
          if (idx < 16 * 15 * 16) { const float* h = p.st_b + ((size_t)(li * NSB + bseq0 + seq) * 15 + hr) * BR + g * 128 + pc * 8; h0[k] = *(const f32x4*)h; h1[k] = *(const f32x4*)(h + 4); } }
#pragma unroll
      for (int k = 0; k < 4; ++k) { const int idx = tid + NT * k, row = idx >> 4, pc = idx & 15; *(LAS u32x4*)(pe + ((row >> 3) * 23 + 15 + (row & 7)) * 128 + pc * 8) = zr[k]; }
#pragma unroll
      for (int k = 0; k < 8; ++k) { const int idx = tid + NT * k, pc = idx & 15, sr = idx >> 4, seq = sr / 15, hr = sr - seq * 15;
          if (idx < 16 * 15 * 16) { u32x4 w; w.x = pk2(h0[k].x, h0[k].y); w.y = pk2(h0[k].z, h0[k].w); w.z = pk2(h1[k].x, h1[k].y); w.w = pk2(h1[k].z, h1[k].w);
              *(LAS u32x4*)(pe + (seq * 23 + hr) * 128 + pc * 8) = w; } } }
    __syncthreads();
#pragma unroll 1
    for (int k = 0; k < 4; ++k) { const int idx = tid + NT * k, row = idx >> 4, pc = idx & 15, ch = g * 128 + pc * 8, m = m0 + row, t = row & 7, b = bseq0 + (row >> 3);
        const LAS bf16_t* pp = pe + ((row >> 3) * 23 + 15 + t) * 128 + pc * 8;
        float sum[8], pv[8]; unpack8(*(const LAS u32x4*)pp, pv);
#pragma unroll
        for (int e = 0; e < 8; ++e) sum[e] = pv[e];
#pragma unroll
        for (int kk = 1; kk < W; ++kk) { float a8[8]; unpack8(*(const LAS u32x4*)(pp - kk * 128), a8);
#pragma unroll
            for (int e = 0; e < 8; ++e) sum[e] += a8[e]; }
        const float ic = 1.f / (float)W; float dv[8];
#pragma unroll
        for (int e = 0; e < 8; ++e) dv[e] = sum[e] * ic - pv[e];
        *(LAS u32x4*)(dT + row * LDP + pc * 8) = pack8(dv);
        float* so = p.out + O_PBS + ((size_t)(li * NSB + b) * 15 + 7 + t) * BR + ch;
        *(f32x4*)so = (f32x4){pv[0], pv[1], pv[2], pv[3]}; *(f32x4*)(so + 4) = (f32x4){pv[4], pv[5], pv[6], pv[7]};
    }
}
__device__ __forceinline__ void mixer_even(const Params& p, int li, LAS unsigned char* lds, int part, int bfirst, unsigned* ctr) {
    int tid_ = threadIdx.x; asm volatile("" : "+v"(tid_));
    const int tid = tid_, lane = tid & 63, wave = tid >> 6, fr = lane & 15, fq = lane >> 4;
    const bf16_t* Z = (const bf16_t*)(p.ws + WS_Z); bf16_t* Y = (bf16_t*)(p.ws + WS_Y);
    constexpr int NA = M / 64, NB = (M / 128) * 4;
    ItemFeed feed; feed.init(ctr, (volatile LAS int*)(lds + 131072 + 128), part ? 48 : 768, bfirst);
    for (; feed.have(); feed.advance()) {
        feed.prefetch();
        const int j = feed.cur;
        const int it = part ? (j < 16 ? 256 + j : NA + 512 + (j - 16)) : (j < 256 ? NA + 2 * j : (j < 512 ? NA + 2 * (j - 256) + 1 : j - 512));
        int tq_ = tid_; asm volatile("" : "+v"(tq_)); const int tid = tq_, lane = tid & 63, wave = tid >> 6, fr = lane & 15, fq = lane >> 4;
        if (it < NA) {
            const int m0 = it * 64 + wave * 8, c0 = lane * 8; const bool samp = m0 >= MP;
            float s1[8], s2[8], w0[8], w1[8], w2[8];
            { const float* cw = p.conv_a_w + (size_t)li * 3 * BR + c0;
#pragma unroll
              for (int e = 0; e < 8; ++e) { w0[e] = cw[e]; w1[e] = cw[BR + e]; w2[e] = cw[2 * BR + e]; } }
            if (samp) { const int b = (m0 - MP) >> 3; const float* h = p.st_a + ((size_t)(li * NSB + b) * 2) * BR + c0;
#pragma unroll
                for (int e = 0; e < 8; ++e) { s2[e] = h[e]; s1[e] = h[BR + e]; } }
            else if ((m0 & (SEQ - 1)) == 0) {
#pragma unroll
                for (int e = 0; e < 8; ++e) { s2[e] = 0.f; s1[e] = 0.f; } }
            else {
                unpack8(*(const u32x4*)(Z + (size_t)(m0 - 2) * NZ + c0), s2); unpack8(*(const u32x4*)(Z + (size_t)(m0 - 1) * NZ + c0), s1);
            }
#pragma unroll
            for (int r = 0; r < 8; ++r) {
                const bf16_t* zr = Z + (size_t)(m0 + r) * NZ + c0;
                float s0[8], bs[8], y[8];
                unpack8(*(const u32x4*)(zr), s0); unpack8(*(const u32x4*)(zr + BR), bs);
#pragma unroll
                for (int e = 0; e < 8; ++e) { const float cv = w0[e] * s2[e] + w1[e] * s1[e] + w2[e] * s0[e]; y[e] = bs[e] * cv; s2[e] = s1[e]; s1[e] = s0[e]; }
                *(u32x4*)(Y + (size_t)(m0 + r) * D + c0) = pack8(y);
                if (r >= 6 && (samp || (m0 & (SEQ - 1)) == SEQ - 8)) {
                    float* so = samp ? p.out + O_CAS + ((size_t)(li * NSB + ((m0 - MP) >> 3)) * 2 + (r - 6)) * BR + c0 : p.out + O_CAP + ((size_t)(li * 8 + (m0 >> 11)) * 2 + (r - 6)) * BR + c0;
                    *(f32x4*)so = (f32x4){s1[0], s1[1], s1[2], s1[3]}; *(f32x4*)(so + 4) = (f32x4){s1[4], s1[5], s1[6], s1[7]}; }
            }
        } else {
            const int q = it - NA, rb = q >> 2, g = ((q & 3) + (q >> 8)) & 3, m0 = rb * 128; const bool samp = m0 >= MP;
            LAS bf16_t* dT = (LAS bf16_t*)lds;
            const bf16_t* pw = (const bf16_t*)(p.ws + WS_PWT) + (size_t)(li * 4 + g) * 128 * 128;
            LAS bf16_t* pwl = dT + 128 * LDP;
            u32x4 pwr[4];
#pragma unroll
            for (int k = 0; k < 4; ++k) { const int idx = tid + NT * k; pwr[k] = *(const u32x4*)(pw + (idx >> 4) * 128 + (idx & 15) * 8); }
            switch (g) { case 0: pool_d_tile<2>(p, li, g, m0, samp, tid, dT); break; case 1: pool_d_tile<4>(p, li, g, m0, samp, tid, dT); break;
                         case 2: pool_d_tile<8>(p, li, g, m0, samp, tid, dT); break; default: pool_d_tile<16>(p, li, g, m0, samp, tid, dT); break; }
            const int m = m0 + 16 * wave + fr;
            u32x4 gbr[4];
#pragma unroll
            for (int t = 0; t < 4; ++t) gbr[t] = *(const u32x4*)(Z + (size_t)m * NZ + 1536 + g * 128 + 32 * fq + 8 * t);
            if (samp) __syncthreads();
#pragma unroll
            for (int k = 0; k < 4; ++k) { const int idx = tid + NT * k, C = idx >> 4; *(LAS u32x4*)(pwl + (16 * ((C >> 2) & 7) + 4 * (C >> 5) + (C & 3)) * LDP + (idx & 15) * 8) = pwr[k]; }
            __syncthreads();
            f32x4 acc[8];
#pragma unroll
            for (int n = 0; n < 8; ++n) acc[n] = (f32x4){0.f, 0.f, 0.f, 0.f};
#pragma unroll
            for (int ks = 0; ks < 4; ++ks) {
                const bf16x8 af = *(const LAS bf16x8*)(dT + (16 * wave + fr) * LDP + 32 * ks + 8 * fq);
#pragma unroll
                for (int n = 0; n < 8; ++n) { const bf16x8 bf = *(const LAS bf16x8*)(pwl + (16 * n + fr) * LDP + 32 * ks + 8 * fq);
                    acc[n] = __builtin_amdgcn_mfma_f32_16x16x32_bf16(bf, af, acc[n], 0, 0, 0); }
            }
#pragma unroll
            for (int t = 0; t < 4; ++t) { float gb[8]; unpack8(gbr[t], gb);
                u32x4 o; o.x = pk2(acc[2 * t][0] * gb[0], acc[2 * t][1] * gb[1]); o.y = pk2(acc[2 * t][2] * gb[2], acc[2 * t][3] * gb[3]);
                o.z = pk2(acc[2 * t + 1][0] * gb[4], acc[2 * t + 1][1] * gb[5]); o.w = pk2(acc[2 * t + 1][2] * gb[6], acc[2 * t + 1][3] * gb[7]);
                *(u32x4*)(Y + (size_t)m * D + BR + g * 128 + 32 * fq + 8 * t) = o; }
            __syncthreads();
        }
    }
}

template <int R, bool SAMP>
__device__ __forceinline__ void conv_item(const Params& p, int li, int idx, LAS unsigned char* lds, const f32x2 (&w2)[31], const f32x2 bias2) {
    int tid_ = threadIdx.x; asm volatile("" : "+v"(tid_));
    const int tid = tid_, lane = tid & 63, wave = tid >> 6, c = tid;
    const bf16_t* Z = (const bf16_t*)(p.ws + WS_Z); bf16_t* Y = (bf16_t*)(p.ws + WS_Y);
    const int m0 = SAMP ? MP + idx * DSEQ : idx * R;
    const int t0 = SAMP ? 0 : (m0 & (SEQ - 1));
    constexpr int NR = R + 30, NIT = (NR * 64 + NT - 1) / NT;
    LAS float* gl = (LAS float*)lds;
    LAS float* st = (LAS float*)(lds + NR * BR * 4);
    u32x4 ra[NIT], rb[NIT];
#pragma unroll
    for (int k = 0; k < NIT; ++k) { const int i2 = tid + NT * k, row = i2 >> 6, cg = i2 & 63, t = t0 - 30 + row;
        ra[k] = (u32x4){0u, 0u, 0u, 0u}; rb[k] = (u32x4){0u, 0u, 0u, 0u};
        if (i2 < NR * 64) {
            if (SAMP && row < 30) { const float* h = p.st_d + ((size_t)(li * NSB + idx) * 30 + row) * BR + cg * 8; ra[k] = *(const u32x4*)h; rb[k] = *(const u32x4*)(h + 4); }
            else if (t >= 0) ra[k] = *(const u32x4*)(Z + (size_t)(m0 - 30 + row) * NZ + 1024 + cg * 8); } }
#pragma unroll
    for (int k = 0; k < NIT; ++k) { const int i2 = tid + NT * k, row = i2 >> 6, cg = i2 & 63, t = t0 - 30 + row;
        if (i2 < NR * 64) { f32x4 g0, g1;
            if (SAMP && row < 30) { g0 = __builtin_bit_cast(f32x4, ra[k]); g1 = __builtin_bit_cast(f32x4, rb[k]); }
            else { float av[8]; unpack8(ra[k], av);
                g0 = (f32x4){av[0], av[1], av[2], av[3]}; g1 = (f32x4){av[4], av[5], av[6], av[7]};
                if (SAMP) { float* so = p.out + O_CDS + ((size_t)(li * NSB + idx) * 30 + (row - 8)) * BR + cg * 8; *(f32x4*)so = g0; *(f32x4*)(so + 4) = g1; }
                else if (row >= 32 && t0 == SEQ - 32) { float* so = p.out + O_CDP + ((size_t)(li * 8 + (m0 >> 11)) * 30 + (row - 32)) * BR + cg * 8; *(f32x4*)so = g0; *(f32x4*)(so + 4) = g1; } }
            *(LAS f32x4*)(gl + row * BR + cg * 8) = g0; *(LAS f32x4*)(gl + row * BR + cg * 8 + 4) = g1; } }
    constexpr int RH = R / 2;
    const int c2 = (tid & 255) * 2, rbase = (tid >> 8) * RH;
    const int cgf = tid & 63;
    const f32x4 lg0 = *(const f32x4*)(p.cln_g + li * BR + cgf * 8), lg1 = *(const f32x4*)(p.cln_g + li * BR + cgf * 8 + 4);
    const f32x4 lb0 = *(const f32x4*)(p.cln_b + li * BR + cgf * 8), lb1 = *(const f32x4*)(p.cln_b + li * BR + cgf * 8 + 4);
    u32x4 gdr[R * 64 / NT];
#pragma unroll
    for (int k = 0; k < R * 64 / NT; ++k) gdr[k] = *(const u32x4*)(Z + (size_t)(m0 + ((tid + NT * k) >> 6)) * NZ + 1536 + cgf * 8);
    __syncthreads();
    f32x2 y2[RH];
#pragma unroll
    for (int o4 = 0; o4 < RH / 4; ++o4) { f32x2 g2[34];
#pragma unroll
        for (int i = 0; i < 34; ++i) g2[i] = *(const LAS f32x2*)(gl + (rbase + 4 * o4 + i) * BR + c2);
#pragma unroll
        for (int q = 0; q < 4; ++q) { f32x2 acc = bias2;
#pragma unroll
            for (int j = 0; j < 31; ++j) acc += w2[j] * g2[q + j];
            y2[4 * o4 + q] = acc; } }
    __syncthreads();
#pragma unroll
    for (int o = 0; o < RH; ++o) *(LAS f32x2*)(gl + (rbase + o) * BR + c2) = y2[o];
    __syncthreads();
    for (int o = wave; o < R; o += NWAVES) {
        float v[8]; float sm = 0.f;
#pragma unroll
        for (int k = 0; k < 8; ++k) { v[k] = gl[o * BR + lane + 64 * k]; sm += v[k]; }
        const float mean = wave_sum(sm) * (1.f / BR); float qv = 0.f;
#pragma unroll
        for (int k = 0; k < 8; ++k) { const float dd = v[k] - mean; qv += dd * dd; }
        const float rs = rsqrtf(wave_sum(qv) * (1.f / BR) + EPS);
        if (lane == 0) { st[2 * o] = mean; st[2 * o + 1] = rs; }
    }
    __syncthreads();
#pragma unroll
    for (int k = 0; k < R * 64 / NT; ++k) { const int i2 = tid + NT * k, o = i2 >> 6, cg = i2 & 63;
        const f32x4 y0 = *(const LAS f32x4*)(gl + o * BR + cg * 8), y1 = *(const LAS f32x4*)(gl + o * BR + cg * 8 + 4);
        const float mean = st[2 * o], rs = st[2 * o + 1];
        float gd[8], ov[8]; unpack8(gdr[k], gd);
#pragma unroll
        for (int e = 0; e < 4; ++e) { ov[e] = siluf_((y0[e] - mean) * rs * lg0[e] + lb0[e]) * gd[e]; ov[4 + e] = siluf_((y1[e] - mean) * rs * lg1[e] + lb1[e]) * gd[4 + e]; }
        *(u32x4*)(Y + (size_t)(m0 + o) * D + BR + cg * 8) = pack8(ov); }
    __syncthreads();
}

__device__ __forceinline__ void mixer_odd(const Params& p, int li, LAS unsigned char* lds, int part, int bfirst, unsigned* ctr) {
    int tid_ = threadIdx.x; asm volatile("" : "+v"(tid_));
    const int tid = tid_, lane = tid & 63, wave = tid >> 6, fr = lane & 15, fq = lane >> 4;
    const bf16_t* Z = (const bf16_t*)(p.ws + WS_Z); bf16_t* Y = (bf16_t*)(p.ws + WS_Y);
    constexpr int NC = (M / 128) * 4, NDP = MP / 32, NDS = NSB;
    f32x2 cw2[31]; f32x2 cb2;
    { const int c2 = (tid_ & 255) * 2;
#pragma unroll
      for (int j = 0; j < 31; ++j) cw2[j] = *(const f32x2*)(p.dw_w + ((size_t)li * 31 + j) * BR + c2);
      cb2 = *(const f32x2*)(p.dw_b + li * BR + c2); }
    ItemFeed feed; feed.init(ctr, (volatile LAS int*)(lds + 131072 + 128), part ? 160 : 1024, bfirst);
    for (; feed.have(); feed.advance()) {
        feed.prefetch();
        const int j = feed.cur;
        const int it = part ? (j < 32 ? 512 + j : NC + NDP + (j - 32)) : (j < 512 ? j : NC + (j - 512));
        int tq_ = tid_; asm volatile("" : "+v"(tq_)); const int tid = tq_, lane = tid & 63, wave = tid >> 6, fr = lane & 15, fq = lane >> 4;
        if (it < NC) {
            const int rb = it >> 2, g = ((it & 3) + (it >> 8)) & 3, m0 = rb * 128; const bool samp = m0 >= MP;
            LAS bf16_t* Al = (LAS bf16_t*)lds;
            LAS bf16_t* vT = (LAS bf16_t*)(lds + 128 * LDP * 2);
            const float* stat = (const float*)(p.ws + WS_STAT) + ((size_t)li * M + m0) * 2;
            const bf16_t* sw = (const bf16_t*)(p.ws + WS_SGW) + (size_t)(li * 4 + g) * 128 * 128;
            const int ks_hi = wave >> 1, ks_lo = samp ? ks_hi : 0;
            bf16x8 wfr[4];
#pragma unroll
            for (int ks = 0; ks < 4; ++ks) { wfr[ks] = (bf16x8){0, 0, 0, 0, 0, 0, 0, 0};
                if (ks >= ks_lo && ks <= ks_hi) { if (!samp) wfr[ks] = *(const bf16x8*)(sw + (16 * wave + fr) * 128 + 32 * ks + 8 * fq);
                    else if (((16 * wave + fr) >> 3) == 4 * ks + fq) wfr[ks] = *(const bf16x8*)(sw + (fr & 7) * 128); } }
            const int m = m0 + 16 * wave + fr;
            u32x4 ur[4];
#pragma unroll
            for (int t = 0; t < 4; ++t) ur[t] = *(const u32x4*)(Z + (size_t)m * NZ + g * 128 + 32 * fq + 8 * t);
            { const int pc = tid >> 5, ch = g * 128 + pc * 8, j0 = tid & 31;
              const f32x4 lg0 = *(const f32x4*)(p.sgu_ln_g + li * BR + ch), lg1 = *(const f32x4*)(p.sgu_ln_g + li * BR + ch + 4);
              const f32x4 lb0 = *(const f32x4*)(p.sgu_ln_b + li * BR + ch), lb1 = *(const f32x4*)(p.sgu_ln_b + li * BR + ch + 4);
              u32x4 vr[4]; f32x2 sq2[4];
#pragma unroll
              for (int k = 0; k < 4; ++k) { const int j = j0 + 32 * k; vr[k] = *(const u32x4*)(Z + (size_t)(m0 + j) * NZ + BR + ch); sq2[k] = *(const f32x2*)(stat + 2 * j); }
#pragma unroll
              for (int k = 0; k < 4; ++k) { const int j = j0 + 32 * k; float v[8]; unpack8(vr[k], v);
                const float mu = sq2[k].x * (1.f / BR), rs = rsqrtf(fmaxf(sq2[k].y * (1.f / BR) - mu * mu, 0.f) + EPS);
#pragma unroll
                for (int e = 0; e < 4; ++e) { v[e] = (v[e] - mu) * rs * lg0[e] + lb0[e]; v[4 + e] = (v[4 + e] - mu) * rs * lg1[e] + lb1[e]; }
#pragma unroll
                for (int e = 0; e < 8; ++e) vT[(16 * ((2 * pc + (e >> 2)) & 7) + 4 * (pc >> 2) + (e & 3)) * LDP + j] = (bf16_t)f2bf(v[e]);
                if (samp) { float* so = p.out + O_CV + ((size_t)li * MS + (m0 - MP) + j) * BR + ch; *(f32x4*)so = (f32x4){v[0], v[1], v[2], v[3]}; *(f32x4*)(so + 4) = (f32x4){v[4], v[5], v[6], v[7]}; } } }
            __syncthreads();
            f32x4 acc[8];
#pragma unroll
            for (int n = 0; n < 8; ++n) acc[n] = (f32x4){0.f, 0.f, 0.f, 0.f};
#pragma unroll
            for (int ks = 0; ks < 4; ++ks) { if (ks < ks_lo || ks > ks_hi) continue;
                const bf16x8 wf = wfr[ks];
#pragma unroll
                for (int n = 0; n < 8; ++n) { const bf16x8 vf = *(const LAS bf16x8*)(vT + (16 * n + fr) * LDP + 32 * ks + 8 * fq);
                    acc[n] = __builtin_amdgcn_mfma_f32_16x16x32_bf16(vf, wf, acc[n], 0, 0, 0); }
            }
            const int pos = samp ? (m & 7) : (m & 127);
            const float bias = p.sgu_b[(size_t)(li * 4 + g) * 128 + pos];
#pragma unroll
            for (int t = 0; t < 4; ++t) { float u[8]; unpack8(ur[t], u);
                u32x4 o; o.x = pk2(u[0] * (acc[2 * t][0] + bias), u[1] * (acc[2 * t][1] + bias)); o.y = pk2(u[2] * (acc[2 * t][2] + bias), u[3] * (acc[2 * t][3] + bias));
                o.z = pk2(u[4] * (acc[2 * t + 1][0] + bias), u[5] * (acc[2 * t + 1][1] + bias)); o.w = pk2(u[6] * (acc[2 * t + 1][2] + bias), u[7] * (acc[2 * t + 1][3] + bias));
                *(u32x4*)(Y + (size_t)m * D + g * 128 + 32 * fq + 8 * t) = o; }
            __syncthreads();
        } else if (it < NC + NDP) conv_item<32, false>(p, li, it - NC, lds, cw2, cb2);
        else conv_item<8, true>(p, li, it - NC - NDP, lds, cw2, cb2);
    }
}

#define XB_TMO      128
#define XB_XCNT(j)  (256  + 64 * (j))
#define XB_XSUB(j)  (1280 + 64 * (j))
#define XB_XGEN(j)  (2304 + 64 * (j))
#define XB_TOP      3328
#define XB_TOPGEN   3392
#define XCD_BAR_WORDS 3456
#define XB_SPIN_CAP (1u << 18)
__device__ __forceinline__ unsigned xb_ld(unsigned* p)              { return __hip_atomic_load(p, __ATOMIC_RELAXED, __HIP_MEMORY_SCOPE_AGENT); }
__device__ __forceinline__ unsigned xb_add(unsigned* p, unsigned v) { return __hip_atomic_fetch_add(p, v, __ATOMIC_RELAXED, __HIP_MEMORY_SCOPE_AGENT); }
__device__ __forceinline__ unsigned xb_xcc_id() { return (unsigned)__builtin_amdgcn_s_getreg((3 << 11) | 20) & 0xFu; }
#define XB_SPIN(cond, bar) do { unsigned _sp = 0; while (cond) { __builtin_amdgcn_s_sleep(1); \
    if ((++_sp & 255u) == 0u) { if (xb_ld(&(bar)[XB_TMO])) break; if (_sp > XB_SPIN_CAP) { atomicAdd(&(bar)[XB_TMO], 1u); break; } } } } while (0)
struct XcdBarrier { unsigned* bar; unsigned x; volatile LAS unsigned* st; };
__device__ __forceinline__ XcdBarrier xcd_barrier_post(unsigned* bar, volatile LAS unsigned* st) {
    XcdBarrier b; b.bar = bar; b.x = xb_xcc_id(); b.st = st;
    if (threadIdx.x == 0) (void)xb_add(&bar[XB_XCNT(b.x)], 1u);
    return b;
}
__device__ __forceinline__ void xcd_barrier_complete(unsigned* bar, unsigned x, unsigned& nloc, unsigned& nx) {
    const unsigned G = gridDim.x * gridDim.y * gridDim.z;
    unsigned sum, cnt, mine, sp = 0u;
    for (;;) {
        sum = 0u; cnt = 0u; mine = 0u;
#pragma unroll
        for (unsigned j = 0; j < 16; ++j) { const unsigned c = xb_ld(&bar[XB_XCNT(j)]); sum += c; cnt += (c > 0u) ? 1u : 0u; mine = (j == x) ? c : mine; }
        if (sum == G) break;
        __builtin_amdgcn_s_sleep(1);
        if ((++sp & 255u) == 0u) { if (xb_ld(&bar[XB_TMO])) break; if (sp > XB_SPIN_CAP) { atomicAdd(&bar[XB_TMO], 1u); break; } }
    }
    nloc = mine > 0u ? mine : 1u; nx = cnt > 0u ? cnt : 1u;
}
__device__ __forceinline__ void xcd_barrier(const XcdBarrier& b) {
    asm volatile("s_waitcnt vmcnt(0)" ::: "memory");
    __syncthreads();
    if (threadIdx.x == 0) {
        unsigned* bar = b.bar; const unsigned bx = xb_xcc_id();
        __builtin_amdgcn_s_waitcnt(0);
        unsigned nloc = b.st[0], nx = b.st[1];
        if (nloc == 0u) { xcd_barrier_complete(bar, bx, nloc, nx); b.st[0] = nloc; b.st[1] = nx; }
        const unsigned old = xb_add(&bar[XB_XSUB(bx)], 1u);
        const unsigned gen = old / nloc;
        if (old + 1u == (gen + 1u) * nloc) {
            __builtin_amdgcn_fence(__ATOMIC_RELEASE, "agent");
            asm volatile("s_waitcnt vmcnt(0)" ::: "memory");
            const unsigned og = xb_add(&bar[XB_TOP], 1u);
            const unsigned tg = og / nx;
            if (og + 1u == (tg + 1u) * nx) xb_add(&bar[XB_TOPGEN], 1u);
            else XB_SPIN(xb_ld(&bar[XB_TOPGEN]) == tg, bar);
            __builtin_amdgcn_fence(__ATOMIC_ACQUIRE, "agent");
            xb_add(&bar[XB_XGEN(bx)], 1u);
            asm volatile("s_waitcnt vmcnt(0)" ::: "memory");
        } else {
            XB_SPIN(xb_ld(&bar[XB_XGEN(bx)]) == gen, bar);
            __builtin_amdgcn_fence(__ATOMIC_ACQUIRE, "agent");
            asm volatile("s_waitcnt vmcnt(0)" ::: "memory");
        }
    }
    __syncthreads();
}

__global__ void __launch_bounds__(NT, 2) fwd_megakernel(Params p) {
    extern __shared__ __attribute__((aligned(16))) unsigned char lds_raw[];
    LAS unsigned char* lds = (LAS unsigned char*)lds_raw;
    cg::grid_group grid = cg::this_grid();
    if (p.ph_hi > 1000) grid.sync();
    for (int u = threadIdx.x; u < 64; u += NT) ((LAS unsigned*)(lds + 131072))[u] = 0u;
    __syncthreads();
    XcdBarrier bar = xcd_barrier_post((unsigned*)p.ws, (volatile LAS unsigned*)(lds + 131072) + 8);
    weights_phase(p, lds, 0, 0);
    prologue(p, lds);
    xcd_barrier(bar);
    const int bf_g1 = gridDim.x >= 128 ? 48 : 0, bf_g2 = gridDim.x >= 128 ? 32 : 0;
#pragma unroll 1
    for (int ph = 0; ph <= 16; ++ph) {
        const int kind = ph & 3, l = ph >> 2;
        if (ph < 16) {
            const bool sp = (kind & 1) != 0, inproj = kind < 2; const int r0 = sp ? MP : 0, nr = sp ? MS : MP, N = inproj ? NIN : D;
            const bf16_t* A = (const bf16_t*)(p.ws + (inproj ? WS_XB : WS_Y)) + (size_t)r0 * D;
            const bf16_t* Bt = inproj ? (const bf16_t*)(p.ws + WS_WIN) + (size_t)l * NIN * D : (const bf16_t*)(p.ws + WS_WOUT) + (size_t)l * D * D;
            bf16_t* C = inproj ? (bf16_t*)(p.ws + WS_Z) + (size_t)r0 * NZ : (bf16_t*)(p.ws + (sp ? WS_OS : WS_Z));
            const bool ksplit = kind == 3;
            pg8::Gemm g{A, Bt, nr, N, ksplit ? D / 2 : D, D};
            pg8::StaticOrder S; S.init(nr, N, gridDim.x, blockIdx.x, ksplit ? D : 0);
            pg8::EpiZ E{C, inproj ? NZ : D, inproj ? (const float*)(p.ws + WS_RSTD) + r0 : nullptr, (inproj && (l & 1)) ? (float*)(p.ws + WS_STAT) + ((size_t)(l >> 1) * M + r0) * 2 : nullptr, inproj ? ((l & 1) ? 2 : 1) : 0, (size_t)MS * D};
            pg8::gemm_phase<pg8::EpiZ, pg8::StaticOrder, true, true>(lds, g, S, E);
        }
        if (kind == 1 || kind == 2) { const int part = kind == 2 ? 1 : 0; unsigned* ctr = part ? nullptr : (unsigned*)p.ws + 3584 + 64 * l;
            if (l & 1) mixer_odd(p, l >> 1, lds, part, 0, ctr); else mixer_even(p, l >> 1, lds, part, 0, ctr); }
        if ((kind == 0 && l > 0) || kind == 3) { const bool pr = kind == 3; post_phase(p, pr ? l : l - 1, pr ? 0 : MP, pr ? MP : M, pr ? bf_g2 : 0); }
        if (kind == 2 && l < 3) weights_phase(p, lds, l + 1, gridDim.x >= 256 ? ((l & 1) ? 160 : 48) : 0);
        if (ph < 16) xcd_barrier(bar);
    }
}

extern "C" void kernel_launch(void* const* d_in, const int* in_sizes, int n_in, void* d_out, int out_size, void* d_ws, size_t ws_size, hipStream_t stream) {
    static int grid = 0;
    if (grid == 0) {
        if (n_in != 22 || (size_t)out_size != O_END || ws_size < WS_END) { fprintf(stderr, "kernel_launch: unexpected shapes (n_in %d out %d ws %zu)\n", n_in, out_size, ws_size); grid = -1; return; }
        int dev = 0, cus = 0, per_cu = 0;
        hipGetDevice(&dev); hipDeviceGetAttribute(&cus, hipDeviceAttributeMultiprocessorCount, dev);
        if (hipFuncSetAttribute((const void*)fwd_megakernel, hipFuncAttributeMaxDynamicSharedMemorySize, LDS_BYTES) != hipSuccess) { fprintf(stderr, "kernel_launch: hipFuncSetAttribute failed\n"); grid = -1; return; }
        if (hipOccupancyMaxActiveBlocksPerMultiprocessor(&per_cu, (const void*)fwd_megakernel, NT, LDS_BYTES) != hipSuccess || per_cu < 1) { fprintf(stderr, "kernel_launch: occupancy query says %d\n", per_cu); per_cu = 1; }
        (void)hipGetLastError();
        grid = cus * (per_cu > 1 ? 1 : per_cu);
    }
    if (grid < 0) return;
    if (hipMemsetAsync(d_ws, 0, 16384, stream) != hipSuccess) { fprintf(stderr, "kernel_launch: memset failed\n"); return; }
    Params p{};
    const float** f = (const float**)&p;
    for (int i = 0; i < 22; ++i) f[i] = (const float*)d_in[i];
    p.out = (float*)d_out; p.ws = (unsigned char*)d_ws;
    p.ph_lo = 0; p.ph_hi = 17;
    void* args[] = {&p};
    hipError_t e = hipLaunchCooperativeKernel((const void*)fwd_megakernel, dim3(grid), dim3(NT), args, LDS_BYTES, stream);
    if (e != hipSuccess) fprintf(stderr, "cooperative launch failed: %s (grid %d)\n", hipGetErrorString(e), grid);
}
```

```cpp
#include <hip/hip_runtime.h>
#include <hip/hip_cooperative_groups.h>
#include <cstdio>
#include <cstdint>
namespace cg = cooperative_groups;

#define LAS __attribute__((address_space(3)))
typedef unsigned short bf16_t;
typedef short bf16x8 __attribute__((ext_vector_type(8)));
typedef float f32x4 __attribute__((ext_vector_type(4)));
typedef float f32x2 __attribute__((ext_vector_type(2)));
typedef unsigned u32x4 __attribute__((ext_vector_type(4)));
typedef unsigned u32x2 __attribute__((ext_vector_type(2)));

namespace pg8 {
constexpr int BM = 256, BK = 64, HALF = 128, HTB = HALF * BK * 2, STAGE_BYTES = 8 * HTB, NXCD = 8, WGM = 8;
__host__ __device__ __forceinline__ int lds_byte(int r, int c) { const int st = (r >> 4) * 2 + (c >> 5), rr = r & 15, cc = c & 31, ob = rr * 64 + cc * 2; return st * 1024 + (ob ^ (((ob >> 9) & 1) << 5)); }
__host__ __device__ __forceinline__ void stage_rc(int b, int& R, int& C) { const int st = b / 1024, sb = b % 1024, swz = sb ^ (((sb >> 9) & 1) << 5); R = (st >> 1) * 16 + swz / 64; C = (st & 1) * 32 + (swz % 64) / 2; }
__host__ __device__ __forceinline__ int perm32(int rho) { const int n = rho >> 4, i = rho & 15; return 8 * (i >> 2) + 4 * n + (i & 3); }
struct Unit { int pm, pn, koff; };
struct Gemm { const bf16_t* A; const bf16_t* Bt; int M, N, K, ld; };
struct StaticOrder {
    int nM, nN, nwg, G, c, ksb;
    __host__ __device__ void init(int M, int N, int G_, int c_, int ksb_ = 0) { nM = M / BM; nN = N / BM; nwg = nM * nN * (ksb_ ? 2 : 1); G = G_; c = c_; ksb = ksb_; }
    __host__ __device__ bool next(int i, Unit& u) const {
        const long L = (long)i * G + c; if (L >= nwg) return false;
        u.koff = 0;
        if (ksb) { const int t = (int)(L >> 1); u.koff = (int)(L & 1) * ksb; u.pm = t / nN; u.pn = t % nN; return true; }
        int wgid = (int)L; { const int q = nwg / NXCD, r = nwg % NXCD, xcd = wgid % NXCD, off = wgid / NXCD; wgid = (xcd < r ? xcd * (q + 1) : r * (q + 1) + (xcd - r) * q) + off; }
        const int nig = WGM * nN, gid = wgid / nig, fm = gid * WGM, gsz = (nM - fm) < WGM ? (nM - fm) : WGM;
        u.pm = fm + ((wgid % nig) % gsz); u.pn = (wgid % nig) / gsz; return true;
    }
    __device__ __forceinline__ void a_ready(const Unit&) const {}
    __device__ __forceinline__ void done(const Unit&) const {}
};
__device__ __forceinline__ unsigned cvt_pk_bf16(float lo, float hi) { unsigned r; asm volatile("v_cvt_pk_bf16_f32 %0, %1, %2" : "=v"(r) : "v"(lo), "v"(hi)); return r; }

__device__ __forceinline__ float ep_sig(float x) { return __builtin_amdgcn_rcpf(1.f + __expf(-x)); }
struct EpiZ {
    static constexpr bool PERM = true, AFTER_DRAIN = false;
    bf16_t* Z; int ldc; const float* rstd; float* stat; int mode; size_t kstride;
    __device__ __forceinline__ void operator()(const f32x4 (&acc)[2][2][4][2], const Unit& u, int wr, int wc, int fr, int fq) const {
        const int row0 = u.pm * BM + wr * 64 + fr;
        if (mode == 0) {
            const int col0 = u.pn * BM + wc * 32 + 8 * fq;
#pragma unroll
            for (int ai = 0; ai < 2; ++ai)
#pragma unroll
                for (int m = 0; m < 4; ++m) { const int row = row0 + ai * HALF + m * 16; const float rs = rstd ? rstd[row] : 1.f; bf16_t* rowp = Z + (u.koff ? kstride : 0) + (size_t)row * ldc + col0;
#pragma unroll
                    for (int bj = 0; bj < 2; ++bj) { const f32x4 v0 = acc[ai][bj][m][0] * rs, v1 = acc[ai][bj][m][1] * rs;
                        u32x4 w; w.x = cvt_pk_bf16(v0[0], v0[1]); w.y = cvt_pk_bf16(v0[2], v0[3]); w.z = cvt_pk_bf16(v1[0], v1[1]); w.w = cvt_pk_bf16(v1[2], v1[3]);
                        *(u32x4*)(rowp + bj * HALF) = w; } }
            return;
        }
        const int q = u.pn >> 2, cb = (u.pn & 3) * 128 + wc * 32 + 8 * fq;
        const int op = mode == 1 ? q : (q == 0 ? 1 : (q == 1 ? 3 : 2));
        const int oc = mode == 1 ? q * 512 : (q == 0 ? 0 : (q == 1 ? 1024 : 512));
#pragma unroll
        for (int ai = 0; ai < 2; ++ai)
#pragma unroll
            for (int m = 0; m < 4; ++m) { const int row = row0 + ai * HALF + m * 16; const float rs = rstd[row]; bf16_t* rowp = Z + (size_t)row * ldc + cb;
                float x[8], y[8], r[8];
#pragma unroll
                for (int e = 0; e < 4; ++e) { x[e] = acc[ai][0][m][0][e] * rs; x[4 + e] = acc[ai][0][m][1][e] * rs; y[e] = acc[ai][1][m][0][e] * rs; y[4 + e] = acc[ai][1][m][1][e] * rs; }
                if (op == 0) {
#pragma unroll
                    for (int e = 0; e < 8; ++e) r[e] = x[e] * y[e]; }
                else if (op == 1) {
#pragma unroll
                    for (int e = 0; e < 8; ++e) r[e] = x[e] * y[e] * ep_sig(y[e]); }
                else if (op == 3) {
#pragma unroll
                    for (int e = 0; e < 8; ++e) r[e] = x[e] * ep_sig(y[e]); }
                else {
#pragma unroll
                    for (int e = 0; e < 8; ++e) r[e] = x[e];
                    u32x4 w2; w2.x = cvt_pk_bf16(y[0] * ep_sig(y[0]), y[1] * ep_sig(y[1])); w2.y = cvt_pk_bf16(y[2] * ep_sig(y[2]), y[3] * ep_sig(y[3]));
                    w2.z = cvt_pk_bf16(y[4] * ep_sig(y[4]), y[5] * ep_sig(y[5])); w2.w = cvt_pk_bf16(y[6] * ep_sig(y[6]), y[7] * ep_sig(y[7]));
                    *(u32x4*)(rowp + 1536) = w2;
                    if (stat) { float sm = ((x[0] + x[1]) + (x[2] + x[3])) + ((x[4] + x[5]) + (x[6] + x[7]));
                        float sq = ((x[0] * x[0] + x[1] * x[1]) + (x[2] * x[2] + x[3] * x[3])) + ((x[4] * x[4] + x[5] * x[5]) + (x[6] * x[6] + x[7] * x[7]));
                        sm += __shfl_xor(sm, 16); sm += __shfl_xor(sm, 32); sq += __shfl_xor(sq, 16); sq += __shfl_xor(sq, 32);
                        if (fq == 0) { __hip_atomic_fetch_add(stat + 2 * row, sm, __ATOMIC_RELAXED, __HIP_MEMORY_SCOPE_AGENT); __hip_atomic_fetch_add(stat + 2 * row + 1, sq, __ATOMIC_RELAXED, __HIP_MEMORY_SCOPE_AGENT); } } }
                u32x4 w; w.x = cvt_pk_bf16(r[0], r[1]); w.y = cvt_pk_bf16(r[2], r[3]); w.z = cvt_pk_bf16(r[4], r[5]); w.w = cvt_pk_bf16(r[6], r[7]);
                *(u32x4*)(rowp + oc) = w; }
    }
};

template <class Epi, class Sched, bool ALIGN_EPI = false, bool SP2 = false>
__device__ __forceinline__ void gemm_phase(LAS unsigned char* lds, const Gemm g, const Sched& S, const Epi& E) {
    int tid_ = threadIdx.x; asm volatile("" : "+v"(tid_));
    const int tid = tid_, wid = __builtin_amdgcn_readfirstlane(tid >> 6), lane = tid & 63, wr = wid >> 2, wc = wid & 3, fr = lane & 15, fq = lane >> 4;
    const int K = g.ld, nt = g.K / BK;
    unsigned voffA[2], voffB[2];
#pragma unroll
    for (int i = 0; i < 2; ++i) { int R, C; stage_rc(tid * 16 + i * 8192, R, C); const int Rb = Epi::PERM ? ((R & ~31) + perm32(R & 31)) : R;
        voffA[i] = (unsigned)(R * K + C) * 2u; voffB[i] = (unsigned)(Rb * K + C) * 2u; }
    const size_t kstep = (size_t)(BK * 2);
    const size_t hstep = (size_t)HALF * K * 2;
    const size_t tstep = 2 * hstep;
    const unsigned ldsw = (unsigned)wid * 1024u;
    const int aoff = lds_byte(wr * 64 + fr, fq * 8), boff = lds_byte(wc * 32 + fr, fq * 8);
#define PG8_SA(b, h) (((b) * 2 + (h)) * HTB)
#define PG8_SB(b, h) ((4 + (b) * 2 + (h)) * HTB)
#define PG8_STAGE(bufoff, gbase, voff) do { _Pragma("unroll") for (int _i = 0; _i < 2; ++_i) \
        __builtin_amdgcn_global_load_lds((const unsigned*)((const char*)(gbase) + (voff)[_i]), (LAS unsigned*)(lds + (bufoff) + ldsw + _i * 8192), 16, 0, 0); } while (0)
#define PG8_LDA(dst, b, h) do { _Pragma("unroll") for (int m = 0; m < 4; ++m) _Pragma("unroll") for (int k = 0; k < 2; ++k) dst[m][k] = *(const LAS bf16x8*)(lds + PG8_SA(b, h) + aoff + m * 2048 + k * 1024); } while (0)
#define PG8_LDB(dst, b, h) do { _Pragma("unroll") for (int n = 0; n < 2; ++n) _Pragma("unroll") for (int k = 0; k < 2; ++k) dst[n][k] = *(const LAS bf16x8*)(lds + PG8_SB(b, h) + boff + n * 2048 + k * 1024); } while (0)
#define PG8_MMA(ai, bj, At, Bt) do { __builtin_amdgcn_s_setprio(1); _Pragma("unroll") for (int m = 0; m < 4; ++m) _Pragma("unroll") for (int n = 0; n < 2; ++n) _Pragma("unroll") for (int k = 0; k < 2; ++k) \
        acc[ai][bj][m][n] = __builtin_amdgcn_mfma_f32_16x16x32_bf16(Bt[n][k], At[m][k], acc[ai][bj][m][n], 0, 0, 0); __builtin_amdgcn_s_setprio(0); } while (0)
#define PG8_WAIT_V(n) asm volatile("s_waitcnt vmcnt(" #n ")" ::: "memory")
#define PG8_WAIT_L(n) asm volatile("s_waitcnt lgkmcnt(" #n ")" ::: "memory")
#define PG8_BAR __builtin_amdgcn_s_barrier()
#define PG8_SCHED __builtin_amdgcn_sched_barrier(0)
    Unit cur, nxt; int ui = 0;
    if (!S.next(0, cur)) return;
    f32x4 acc[2][2][4][2];
#pragma unroll
    for (int a = 0; a < 2; ++a)
#pragma unroll
        for (int b = 0; b < 2; ++b)
#pragma unroll
            for (int m = 0; m < 4; ++m)
#pragma unroll
                for (int n = 0; n < 2; ++n) acc[a][b][m][n] = (f32x4){0.f, 0.f, 0.f, 0.f};
    bf16x8 At[4][2], B0[2][2], B1[2][2];
    const char* cA = (const char*)g.A + (size_t)cur.pm * tstep + cur.koff; const char* cB = (const char*)g.Bt + (size_t)cur.pn * tstep + cur.koff;
    S.a_ready(cur);
    if constexpr (SP2) {
        PG8_STAGE(PG8_SB(0, 0), cB, voffB); PG8_STAGE(PG8_SB(0, 1), cB + hstep, voffB); PG8_STAGE(PG8_SA(0, 0), cA, voffA); PG8_STAGE(PG8_SA(0, 1), cA + hstep, voffA);
        if (wr == 1) PG8_BAR;
        PG8_WAIT_V(2); PG8_BAR;
        PG8_STAGE(PG8_SB(1, 0), cB + kstep, voffB); PG8_STAGE(PG8_SA(1, 0), cA + kstep, voffA); PG8_STAGE(PG8_SB(1, 1), cB + hstep + kstep, voffB);
        PG8_WAIT_V(6); PG8_BAR;
    } else {
        PG8_STAGE(PG8_SB(0, 0), cB, voffB); PG8_STAGE(PG8_SA(0, 0), cA, voffA); PG8_STAGE(PG8_SB(0, 1), cB + hstep, voffB); PG8_STAGE(PG8_SA(0, 1), cA + hstep, voffA);
        if (wr == 1) PG8_BAR;
        PG8_WAIT_V(4); PG8_BAR;
        PG8_STAGE(PG8_SB(1, 0), cB + kstep, voffB); PG8_STAGE(PG8_SA(1, 0), cA + kstep, voffA); PG8_STAGE(PG8_SB(1, 1), cB + hstep + kstep, voffB);
        PG8_WAIT_V(6); PG8_BAR;
    }
    for (;;) {
        const bool has_next = S.next(ui + 1, nxt);
        const char* nA = has_next ? (const char*)g.A + (size_t)nxt.pm * tstep + nxt.koff : cA; const char* nB = has_next ? (const char*)g.Bt + (size_t)nxt.pn * tstep + nxt.koff : cB;
        for (int t = 0; t < nt; t += 2) {
            const bool last = (t == nt - 2);
            const char* a1 = cA + (size_t)(t + 1) * kstep;
            const char* a2 = last ? nA : cA + (size_t)(t + 2) * kstep; const char* b2 = last ? nB : cB + (size_t)(t + 2) * kstep;
            const char* a3 = a2 + kstep; const char* b3 = b2 + kstep;
            if (last && has_next) S.a_ready(nxt);
            if constexpr (SP2) {
            PG8_LDB(B0, 0, 0); PG8_LDB(B1, 0, 1); PG8_SCHED; PG8_LDA(At, 0, 0); PG8_STAGE(PG8_SA(1, 1), a1 + hstep, voffA);
            PG8_WAIT_V(8); PG8_WAIT_L(0); PG8_BAR; PG8_MMA(0, 0, At, B0); PG8_MMA(0, 1, At, B1); PG8_BAR; PG8_SCHED;
            PG8_LDA(At, 0, 1); PG8_STAGE(PG8_SB(0, 0), b2, voffB); PG8_STAGE(PG8_SB(0, 1), b2 + hstep, voffB); PG8_STAGE(PG8_SA(0, 0), a2, voffA);
            PG8_WAIT_V(8); PG8_WAIT_L(0); PG8_BAR; PG8_MMA(1, 0, At, B0); PG8_MMA(1, 1, At, B1); PG8_BAR; PG8_SCHED;
            PG8_LDB(B0, 1, 0); PG8_LDB(B1, 1, 1); PG8_SCHED; PG8_LDA(At, 1, 0); PG8_STAGE(PG8_SA(0, 1), a2 + hstep, voffA);
            PG8_WAIT_V(8); PG8_WAIT_L(0); PG8_BAR; PG8_MMA(0, 0, At, B0); PG8_MMA(0, 1, At, B1); PG8_BAR; PG8_SCHED;
            PG8_LDA(At, 1, 1); PG8_STAGE(PG8_SB(1, 0), b3, voffB); PG8_STAGE(PG8_SB(1, 1), b3 + hstep, voffB); PG8_STAGE(PG8_SA(1, 0), a3, voffA);
            PG8_WAIT_V(8); PG8_WAIT_L(0); PG8_BAR; PG8_MMA(1, 0, At, B0); PG8_MMA(1, 1, At, B1); PG8_BAR; PG8_SCHED;
            } else {
            PG8_LDB(B0, 0, 0); PG8_SCHED; PG8_LDA(At, 0, 0); PG8_STAGE(PG8_SA(1, 1), a1 + hstep, voffA);
            PG8_WAIT_L(8); PG8_BAR; PG8_WAIT_L(0); PG8_MMA(0, 0, At, B0); PG8_BAR; PG8_SCHED;
            PG8_LDB(B1, 0, 1); PG8_STAGE(PG8_SB(0, 0), b2, voffB);
            PG8_BAR; PG8_WAIT_L(0); PG8_MMA(0, 1, At, B1); PG8_BAR;
            PG8_LDA(At, 0, 1); PG8_STAGE(PG8_SA(0, 0), a2, voffA);
            PG8_BAR; PG8_WAIT_L(0); PG8_MMA(1, 0, At, B0); PG8_BAR; PG8_SCHED;
            PG8_STAGE(PG8_SB(0, 1), b2 + hstep, voffB);
            PG8_WAIT_V(6); PG8_BAR; PG8_MMA(1, 1, At, B1); PG8_BAR;
            PG8_LDB(B0, 1, 0); PG8_SCHED; PG8_LDA(At, 1, 0); PG8_STAGE(PG8_SA(0, 1), a2 + hstep, voffA);
            PG8_WAIT_L(8); PG8_BAR; PG8_WAIT_L(0); PG8_MMA(0, 0, At, B0); PG8_BAR; PG8_SCHED;
            PG8_LDB(B1, 1, 1); PG8_STAGE(PG8_SB(1, 0), b3, voffB);
            PG8_BAR; PG8_WAIT_L(0); PG8_MMA(0, 1, At, B1); PG8_BAR;
            PG8_LDA(At, 1, 1); PG8_STAGE(PG8_SA(1, 0), a3, voffA);
            PG8_BAR; PG8_WAIT_L(0); PG8_MMA(1, 0, At, B0); PG8_BAR; PG8_SCHED;
            PG8_STAGE(PG8_SB(1, 1), b3 + hstep, voffB);
            PG8_WAIT_V(6); PG8_BAR; PG8_MMA(1, 1, At, B1); PG8_BAR;
            }
        }
        if constexpr (ALIGN_EPI) { if (wr == 0) PG8_BAR; }
        if constexpr (!Epi::AFTER_DRAIN) { E(acc, cur, wr, wc, fr, fq); S.done(cur); }
        if (!has_next) break;
#pragma unroll
        for (int a = 0; a < 2; ++a)
#pragma unroll
            for (int b = 0; b < 2; ++b)
#pragma unroll
                for (int m = 0; m < 4; ++m)
#pragma unroll
                    for (int n = 0; n < 2; ++n) acc[a][b][m][n] = (f32x4){0.f, 0.f, 0.f, 0.f};
        cur = nxt; cA = nA; cB = nB; ++ui;
        if constexpr (ALIGN_EPI) { if (wr == 1) PG8_BAR; }
    }
    PG8_WAIT_V(0);
    if constexpr (!ALIGN_EPI) { if (wr == 0) PG8_BAR; }
    PG8_BAR;
#undef PG8_SA
#undef PG8_SB
#undef PG8_STAGE
#undef PG8_LDA
#undef PG8_LDB
#undef PG8_MMA
#undef PG8_WAIT_V
#undef PG8_WAIT_L
#undef PG8_BAR
#undef PG8_SCHED
}
}

constexpr int D = 1024, MP = 16384, MS = 1024, M = MP + MS, NIN = 3072, BR = 512, SEQ = 2048, DSEQ = 8, NSB = 128;
constexpr int NZ = 2048;
constexpr float EPS = 1e-6f;
constexpr int NWAVES = 8, NT = 512;
constexpr size_t O_Y = 0;
constexpr size_t O_CAP = (size_t)M * D;
constexpr size_t O_CAS = O_CAP + 2 * 8 * 2 * 512;
constexpr size_t O_PBP = O_CAS + 2 * 128 * 2 * 512;
constexpr size_t O_PBS = O_PBP + 2 * 8 * 15 * 512;
constexpr size_t O_CDP = O_PBS + 2 * 128 * 15 * 512;
constexpr size_t O_CDS = O_CDP + 2 * 8 * 30 * 512;
constexpr size_t O_CV = O_CDS + 2 * 128 * 30 * 512;
constexpr size_t O_END = O_CV + 2 * 128 * 8 * 512;
constexpr size_t MiB = 1u << 20;
constexpr size_t WS_STAT = 65536;
constexpr size_t WS_ZERO_BYTES = WS_STAT + 2 * (size_t)17408 * 2 * 4;
constexpr size_t WS_WIN = 1 * MiB;
constexpr size_t WS_WOUT = 25 * MiB;
constexpr size_t WS_PWT = 33 * MiB;
constexpr size_t WS_SGW = 33 * MiB + 256 * 1024;
constexpr size_t WS_RSTD = 33 * MiB + 512 * 1024;
constexpr size_t WS_XB = 34 * MiB;
constexpr size_t WS_Z = 68 * MiB;
constexpr size_t WS_Y = 170 * MiB;
constexpr size_t WS_OS = 204 * MiB;
constexpr size_t WS_END = 208 * MiB;
constexpr int LDS_BYTES = 147456;

struct Params {
    const float* xp; const float* xs; const float* st_a; const float* st_b; const float* st_d;
    const float* norm_pre; const float* norm_post; const float* w_in_even; const float* w_out_even;
    const float* conv_a_w; const float* pool_w; const float* pool_scale;
    const float* w_in_odd; const float* w_out_odd; const float* sgu_ln_g; const float* sgu_ln_b;
    const float* sgu_w; const float* sgu_b; const float* dw_w; const float* dw_b; const float* cln_g; const float* cln_b;
    float* out; unsigned char* ws; int ph_lo, ph_hi;
};

__device__ __forceinline__ unsigned pk2(float lo, float hi) { unsigned r; asm("v_cvt_pk_bf16_f32 %0, %1, %2" : "=v"(r) : "v"(lo), "v"(hi)); return r; }
__device__ __forceinline__ unsigned f2bf(float f) { return pk2(f, 0.f) & 0xffffu; }
__device__ __forceinline__ float bf2f(unsigned short b) { return __uint_as_float((unsigned)b << 16); }
__device__ __forceinline__ void unpack8(const u32x4 v, float (&f)[8]) {
#pragma unroll
    for (int i = 0; i < 4; ++i) { f[2 * i] = __uint_as_float(v[i] << 16); f[2 * i + 1] = __uint_as_float(v[i] & 0xffff0000u); }
}
__device__ __forceinline__ u32x4 pack8(const float (&f)[8]) { u32x4 w; w.x = pk2(f[0], f[1]); w.y = pk2(f[2], f[3]); w.z = pk2(f[4], f[5]); w.w = pk2(f[6], f[7]); return w; }
__device__ __forceinline__ void unpack4(const u32x2 v, float (&f)[4]) { f[0] = __uint_as_float(v.x << 16); f[1] = __uint_as_float(v.x & 0xffff0000u); f[2] = __uint_as_float(v.y << 16); f[3] = __uint_as_float(v.y & 0xffff0000u); }
__device__ __forceinline__ float sigmoidf_(float x) { return __builtin_amdgcn_rcpf(1.f + __expf(-x)); }
__device__ __forceinline__ float siluf_(float x) { return x * sigmoidf_(x); }
__device__ __forceinline__ float wave_sum(float v) {
#pragma unroll
    for (int o = 1; o < 64; o <<= 1) v += __shfl_xor(v, o);
    return v;
}
__device__ __forceinline__ const float* xin_row(const Params& p, int l, int m) {
    return m < MP ? p.xp + (size_t)m * D : p.xs + (size_t)(m - MP) * D;
}

__device__ __forceinline__ int perm_col(int n0, int pmode) {
    if (pmode == 0) return n0;
    const int sidx = n0 >> 9, c0 = n0 & 511, tb = ((pmode == 1 ? 0x884004 : 0x844080) >> (4 * sidx)) & 15, hf = ((pmode == 1 ? 0x2C : 0x34) >> sidx) & 1;
    return (tb + (c0 >> 7)) * 256 + hf * 128 + (c0 & 127);
}
__device__ __forceinline__ void transpose_item(const float* W, const float* gs, int K, int N, bf16_t* WT, LAS float* scr, int item, int lane, int pmode) {
    const int nblk = N / 32, kb = item / nblk, nb = item % nblk, k0 = 64 * kb, n0 = 32 * nb, nd0 = perm_col(n0, pmode);
    { const int r8 = lane >> 3, c4 = lane & 7; f32x4 v[8]; float sc[8];
#pragma unroll
      for (int i = 0; i < 8; ++i) { const int kk = 8 * i + r8; v[i] = *(const f32x4*)(W + (size_t)(k0 + kk) * N + n0 + 4 * c4); sc[i] = gs ? gs[k0 + kk] : 1.f; }
#pragma unroll
      for (int i = 0; i < 8; ++i) { LAS float* d = scr + (8 * i + r8) * 33 + 4 * c4; d[0] = v[i].x * sc[i]; d[1] = v[i].y * sc[i]; d[2] = v[i].z * sc[i]; d[3] = v[i].w * sc[i]; } }
    asm volatile("s_waitcnt lgkmcnt(0)" ::: "memory");
    const int c = lane & 7;
#pragma unroll
    for (int j = 0; j < 4; ++j) { const int n = (lane >> 3) + 8 * j; const LAS float* s = scr + (8 * c) * 33 + n;
        u32x4 o; o.x = pk2(s[0 * 33], s[1 * 33]); o.y = pk2(s[2 * 33], s[3 * 33]); o.z = pk2(s[4 * 33], s[5 * 33]); o.w = pk2(s[6 * 33], s[7 * 33]);
        *(u32x4*)(WT + (size_t)(nd0 + n) * K + k0 + 8 * c) = o; }
    asm volatile("s_waitcnt lgkmcnt(0)" ::: "memory");
}
__device__ __forceinline__ void weights_phase(const Params& p, LAS unsigned char* lds, int l, int bfirst) {
    int tid_ = threadIdx.x; asm volatile("" : "+v"(tid_));
    const int tid = tid_, lane = tid & 63, wave = tid >> 6;
    if ((int)blockIdx.x < bfirst) return;
    const int gw = ((int)blockIdx.x - bfirst) * NWAVES + wave, NGW = ((int)gridDim.x - bfirst) * NWAVES;
    LAS float* scr = (LAS float*)(lds + wave * 16384);
    bf16_t* wtin = (bf16_t*)(p.ws + WS_WIN) + (size_t)l * NIN * D; bf16_t* wtout = (bf16_t*)(p.ws + WS_WOUT) + (size_t)l * D * D;
    constexpr int I_IN = (D / 64) * (NIN / 32), I_OUT = (D / 64) * (D / 32);
    const float* Wi = ((l & 1) ? p.w_in_odd : p.w_in_even) + (size_t)(l >> 1) * D * NIN; const float* Wo = ((l & 1) ? p.w_out_odd : p.w_out_even) + (size_t)(l >> 1) * D * D;
    for (int it = gw; it < I_IN + I_OUT; it += NGW) {
        if (it < I_IN) transpose_item(Wi, p.norm_pre + l * D, D, NIN, wtin, scr, it, lane, (l & 1) ? 2 : 1);
        else transpose_item(Wo, nullptr, D, D, wtout, scr, it - I_IN, lane, 0);
    }
}
__device__ __forceinline__ void prologue(const Params& p, LAS unsigned char* lds) {
    int tid_ = threadIdx.x; asm volatile("" : "+v"(tid_));
    const int tid = tid_, lane = tid & 63, wave = tid >> 6;
    const int gw = blockIdx.x * NWAVES + wave, NGW = gridDim.x * NWAVES;
    const int gt = blockIdx.x * NT + tid, NGT = gridDim.x * NT;
    bf16_t* pwt = (bf16_t*)(p.ws + WS_PWT); bf16_t* sgw = (bf16_t*)(p.ws + WS_SGW);
    for (int e = gt; e < 2 * 4 * 128 * 128; e += NGT) {
        const int c = e & 127, d = (e >> 7) & 127, lg = e >> 14, g = lg & 3, li = lg >> 2;
        pwt[e] = (bf16_t)f2bf(p.pool_w[((size_t)lg * 128 + c) * 128 + d] * p.pool_scale[li * BR + g * 128 + d]);
        const int j = e & 127, i = (e >> 7) & 127;
        sgw[e] = (bf16_t)f2bf(j <= i ? p.sgu_w[e] : 0.f);
    }
    {
        constexpr int N1 = 2 * NSB * 7 * (BR / 4), N2 = 2 * NSB * 22 * (BR / 4);
        for (int e0 = gt; e0 < N1 + N2; e0 += 4 * NGT) {
            f32x4 v[4]; float* dst[4];
#pragma unroll
            for (int u = 0; u < 4; ++u) { const int e = e0 + u * NGT; dst[u] = nullptr; v[u] = (f32x4){0.f, 0.f, 0.f, 0.f};
                if (e < N1) { const int c4 = e & 127, rr = e >> 7, r = rr % 7, lb = rr / 7;
                    v[u] = *(const f32x4*)(p.st_b + ((size_t)lb * 15 + 8 + r) * BR + c4 * 4); dst[u] = p.out + O_PBS + ((size_t)lb * 15 + r) * BR + c4 * 4; }
                else if (e < N1 + N2) { const int f = e - N1, c4 = f & 127, rr = f >> 7, r = rr % 22, lb = rr / 22;
                    v[u] = *(const f32x4*)(p.st_d + ((size_t)lb * 30 + 8 + r) * BR + c4 * 4); dst[u] = p.out + O_CDS + ((size_t)lb * 30 + r) * BR + c4 * 4; } }
#pragma unroll
            for (int u = 0; u < 4; ++u) if (dst[u]) *(f32x4*)dst[u] = v[u];
        }
    }
    for (int e = gt; e < (int)((WS_ZERO_BYTES - WS_STAT) / 16); e += NGT) *(f32x4*)(p.ws + WS_STAT + (size_t)e * 16) = (f32x4){0.f, 0.f, 0.f, 0.f};
    bf16_t* xb = (bf16_t*)(p.ws + WS_XB); float* rstd = (float*)(p.ws + WS_RSTD);
    for (int mb = gw; mb < M; mb += 2 * NGW) {
        f32x4 v[2][4];
#pragma unroll
        for (int r = 0; r < 2; ++r) { const int mm = mb + r * NGW, m = mm < M ? mm : mb; const f32x4* xr = (const f32x4*)xin_row(p, 0, m) + lane;
#pragma unroll
            for (int j = 0; j < 4; ++j) v[r][j] = xr[64 * j]; }
#pragma unroll
        for (int r = 0; r < 2; ++r) { const int m = mb + r * NGW; float s = 0.f;
#pragma unroll
            for (int j = 0; j < 4; ++j) s += (v[r][j].x * v[r][j].x + v[r][j].y * v[r][j].y) + (v[r][j].z * v[r][j].z + v[r][j].w * v[r][j].w);
            s = wave_sum(s);
            if (m < M) { if (lane == 0) rstd[m] = rsqrtf(s * (1.f / D) + EPS);
                u32x2* o8 = (u32x2*)(xb + (size_t)m * D) + lane;
#pragma unroll
                for (int j = 0; j < 4; ++j) { u32x2 w; w.x = pk2(v[r][j].x, v[r][j].y); w.y = pk2(v[r][j].z, v[r][j].w); o8[64 * j] = w; } } }
    }
}

__device__ __forceinline__ const bf16_t* o_row(const Params& p, int m) { return m < MP ? (const bf16_t*)(p.ws + WS_Z) + (size_t)m * D : (const bf16_t*)(p.ws + WS_OS) + (size_t)(m - MP) * D; }
__device__ __forceinline__ void post_phase(const Params& p, int l, int row_lo, int row_hi, int bfirst) {
    int tid_ = threadIdx.x; asm volatile("" : "+v"(tid_));
    const int tid = tid_, lane = tid & 63, wave = tid >> 6;
    if ((int)blockIdx.x < bfirst) return;
    const int gw = ((int)blockIdx.x - bfirst) * NWAVES + wave, NGW = ((int)gridDim.x - bfirst) * NWAVES;
    bf16_t* xb = (bf16_t*)(p.ws + WS_XB); float* rstd = (float*)(p.ws + WS_RSTD);
    float g[16];
#pragma unroll
    for (int j = 0; j < 2; ++j) { const f32x4 a = *(const f32x4*)(p.norm_post + l * D + lane * 8 + 512 * j), b = *(const f32x4*)(p.norm_post + l * D + lane * 8 + 512 * j + 4);
        g[8 * j] = a.x; g[8 * j + 1] = a.y; g[8 * j + 2] = a.z; g[8 * j + 3] = a.w; g[8 * j + 4] = b.x; g[8 * j + 5] = b.y; g[8 * j + 6] = b.z; g[8 * j + 7] = b.w; }
    constexpr int RPI = 4;
    for (int mb = row_lo + gw; mb < row_hi; mb += RPI * NGW) {
        const bool two = row_lo >= MP;
        u32x4 orw[RPI][2], xrw[RPI][2], o2w[RPI][2];
#pragma unroll
        for (int r = 0; r < RPI; ++r) { const int m = mb + r * NGW; const bool ok = m < row_hi;
#pragma unroll
            for (int j = 0; j < 2; ++j) { const u32x4 z4 = (u32x4){0u, 0u, 0u, 0u};
                orw[r][j] = ok ? *(const u32x4*)(o_row(p, m) + lane * 8 + 512 * j) : z4; xrw[r][j] = ok ? *(const u32x4*)(xb + (size_t)m * D + lane * 8 + 512 * j) : z4;
                o2w[r][j] = (ok && two) ? *(const u32x4*)(o_row(p, m) + (size_t)MS * D + lane * 8 + 512 * j) : z4; } }
#pragma unroll
        for (int r = 0; r < RPI; ++r) { const int m = mb + r * NGW;
            float o[16], x[16]; float ss = 0.f;
#pragma unroll
            for (int j = 0; j < 2; ++j) { float t8[8], u8[8]; unpack8(orw[r][j], t8); unpack8(o2w[r][j], u8);
#pragma unroll
                for (int e = 0; e < 8; ++e) { t8[e] += u8[e]; o[8 * j + e] = t8[e]; ss += t8[e] * t8[e]; }
                unpack8(xrw[r][j], t8);
#pragma unroll
                for (int e = 0; e < 8; ++e) x[8 * j + e] = t8[e]; }
            const float rs = rsqrtf(wave_sum(ss) * (1.f / D) + EPS); float s2 = 0.f;
#pragma unroll
            for (int e = 0; e < 16; ++e) { x[e] += o[e] * rs * g[e]; s2 += x[e] * x[e]; }
            if (l < 3) s2 = wave_sum(s2);
            if (m < row_hi) {
                if (l < 3) {
#pragma unroll
                for (int j = 0; j < 2; ++j) { u32x4 w; w.x = pk2(x[8 * j], x[8 * j + 1]); w.y = pk2(x[8 * j + 2], x[8 * j + 3]); w.z = pk2(x[8 * j + 4], x[8 * j + 5]); w.w = pk2(x[8 * j + 6], x[8 * j + 7]);
                    *(u32x4*)(xb + (size_t)m * D + lane * 8 + 512 * j) = w; }
                if (lane == 0) rstd[m] = rsqrtf(s2 * (1.f / D) + EPS); }
                else {
#pragma unroll
                    for (int j = 0; j < 2; ++j) { float* orow = p.out + (size_t)m * D + lane * 8 + 512 * j;
                        *(f32x4*)orow = (f32x4){x[8 * j], x[8 * j + 1], x[8 * j + 2], x[8 * j + 3]}; *(f32x4*)(orow + 4) = (f32x4){x[8 * j + 4], x[8 * j + 5], x[8 * j + 6], x[8 * j + 7]}; } }
            }
        }
    }
}

struct ItemFeed {
    unsigned* ctr; volatile LAS int* slot; int n, k, cur, nxt, stride;
    __device__ __forceinline__ void init(unsigned* c, volatile LAS int* s, int nItems, int bfirst) {
        ctr = c; slot = s; n = nItems; k = 0; stride = (int)gridDim.x - bfirst;
        if (ctr) { if (threadIdx.x == 0) { slot[0] = (int)__hip_atomic_fetch_add(ctr, 1u, __ATOMIC_RELAXED, __HIP_MEMORY_SCOPE_AGENT); } __syncthreads(); cur = slot[0]; }
        else { cur = (int)blockIdx.x - bfirst; if (cur < 0) cur = n; }
    }
    __device__ __forceinline__ bool have() const { return cur < n; }
    __device__ __forceinline__ void prefetch() { if (ctr && threadIdx.x == 0) nxt = (int)__hip_atomic_fetch_add(ctr, 1u, __ATOMIC_RELAXED, __HIP_MEMORY_SCOPE_AGENT); }
    __device__ __forceinline__ void advance() {
        if (ctr) { ++k; if (threadIdx.x == 0) slot[k & 1] = nxt; __syncthreads(); cur = slot[k & 1]; }
        else cur += stride;
    }
};

constexpr int LDP = 136;
template <int W>
__device__ __forceinline__ void pool_d_tile(const Params& p, int li, int g, int m0, bool samp, int tid, LAS bf16_t* dT) {
    const bf16_t* Z = (const bf16_t*)(p.ws + WS_Z);
    if (!samp) {
        constexpr int RPT = (W >= 16) ? 2 : 4, NL = W + RPT - 1;
#pragma unroll 1
        for (int bt = 0; bt < 4 / RPT; ++bt) {
        const int rseg = bt * 32 + (tid >> 4), pc = tid & 15, ch = g * 128 + pc * 8, mtop = m0 + RPT * rseg + RPT - 1, ttop = mtop & (SEQ - 1);
        const bf16_t* zp = Z + (size_t)mtop * NZ + 1024 + ch;
        u32x4 raw[NL];
#pragma unroll
        for (int i = 0; i < NL; ++i) raw[i] = *(const u32x4*)(zp - (size_t)((ttop - i >= 0) ? i : 0) * NZ);
        float sum[RPT][8];
        const bool first = (m0 & (SEQ - 1)) == 0;
#pragma unroll
        for (int e = 0; e < 8; ++e) sum[0][e] = 0.f;
#pragma unroll
        for (int i = RPT - 1; i < RPT - 1 + W; ++i) { float a[8]; unpack8(raw[i], a);
            if (first) { const float mk = (ttop - i >= 0) ? 1.f : 0.f;
#pragma unroll
                for (int e = 0; e < 8; ++e) a[e] *= mk; }
#pragma unroll
            for (int e = 0; e < 8; ++e) sum[0][e] += a[e]; }
#pragma unroll
        for (int q = 1; q < RPT; ++q) { float a[8], b[8]; unpack8(raw[RPT - 1 - q], a); unpack8(raw[RPT - 1 - q + W], b);
            if (first) { const float mb_ = (ttop - (RPT - 1 - q + W) >= 0) ? 1.f : 0.f;
#pragma unroll
                for (int e = 0; e < 8; ++e) b[e] *= mb_; }
#pragma unroll
            for (int e = 0; e < 8; ++e) sum[q][e] = sum[q - 1][e] + a[e] - b[e]; }
#pragma unroll
        for (int q = 0; q < RPT; ++q) { const int t = ttop - (RPT - 1) + q, m = mtop - (RPT - 1) + q; float pv[8], dv[8]; unpack8(raw[RPT - 1 - q], pv);
            const float ic = 1.f / (float)(t + 1 < W ? t + 1 : W);
#pragma unroll
            for (int e = 0; e < 8; ++e) dv[e] = sum[q][e] * ic - pv[e];
            *(LAS u32x4*)(dT + (RPT * rseg + q) * LDP + pc * 8) = pack8(dv);
            if (t >= SEQ - 15) { float* so = p.out + O_PBP + ((size_t)(li * 8 + (m >> 11)) * 15 + (t - (SEQ - 15))) * BR + ch;
                *(f32x4*)so = (f32x4){pv[0], pv[1], pv[2], pv[3]}; *(f32x4*)(so + 4) = (f32x4){pv[4], pv[5], pv[6], pv[7]}; } }
        }
        return;
    }
    LAS bf16_t* pe = dT + 128 * LDP;
    const int bseq0 = (m0 - MP) >> 3;
    { u32x4 zr[4]; f32x4 h0[8], h1[8];
#pragma unroll
      for (int k = 0; k < 4; ++k) { const int idx = tid + NT * k, row = idx >> 4, pc = idx & 15; zr[k] = *(const u32x4*)(Z + (size_t)(m0 + row) * NZ + 1024 + g * 128 + pc * 8); }
#pragma unroll
      for (int k = 0; k < 8; ++k) { const int idx = tid + NT * k, pc = idx & 15, sr = idx >> 4, seq = sr / 15, hr = sr - seq * 15;
          h0[k] = (f32x4){0.f, 0.f, 0.f, 0.f}; h1[k] = h0[k];
          if (idx < 16 * 15 * 16) { const float* h = p.st_b + ((size_t)(li * NSB + bseq0 + seq) * 15 + hr) * BR + g * 128 + pc * 8; h0[k] = *(const f32x4*)h; h1[k] = *(const f32x4*)(h + 4); } }
#pragma unroll
      for (int k = 0; k < 4; ++k) { const int idx = tid + NT * k, row = idx >> 4, pc = idx & 15; *(LAS u32x4*)(pe + ((row >> 3) * 23 + 15 + (row & 7)) * 128 + pc * 8) = zr[k]; }
#pragma unroll
      for (int k = 0; k < 8; ++k) { const int idx = tid + NT * k, pc = idx & 15, sr = idx >> 4, seq = sr / 15, hr = sr - seq * 15;
          if (idx < 16 * 15 * 16) { u32x4 w; w.x = pk2(h0[k].x, h0[k].y); w.y = pk2(h0[k].z, h0[k].w); w.z = pk2(h1[k].x, h1[k].y); w.w = pk2(h1[k].z, h1[k].w);
              *(LAS u32x4*)(pe + (seq * 23 + hr) * 128 + pc * 8) = w; } } }
    __syncthreads();
#pragma unroll 1
    for (int k = 0; k < 4; ++k) { const int idx = tid + NT * k, row = idx >> 4, pc = idx & 15, ch = g * 128 + pc * 8, m = m0 + row, t = row & 7, b = bseq0 + (row >> 3);
        const LAS bf16_t* pp = pe + ((row >> 3) * 23 + 15 + t) * 128 + pc * 8;
        float sum[8], pv[8]; unpack8(*(const LAS u32x4*)pp, pv);
#pragma unroll
        for (int e = 0; e < 8; ++e) sum[e] = pv[e];
#pragma unroll
        for (int kk = 1; kk < W; ++kk) { float a8[8]; unpack8(*(const LAS u32x4*)(pp - kk * 128), a8);
#pragma unroll
            for (int e = 0; e < 8; ++e) sum[e] += a8[e]; }
        const float ic = 1.f / (float)W; float dv[8];
#pragma unroll
        for (int e = 0; e < 8; ++e) dv[e] = sum[e] * ic - pv[e];
        *(LAS u32x4*)(dT + row * LDP + pc * 8) = pack8(dv);
        float* so = p.out + O_PBS + ((size_t)(li * NSB + b) * 15 + 7 + t) * BR + ch;
        *(f32x4*)so = (f32x4){pv[0], pv[1], pv[2], pv[3]}; *(f32x4*)(so + 4) = (f32x4){pv[4], pv[5], pv[6], pv[7]};
    }
}
__device__ __forceinline__ void mixer_even(const Params& p, int li, LAS unsigned char* lds, int part, int bfirst, unsigned* ctr) {
    int tid_ = threadIdx.x; asm volatile("" : "+v"(tid_));
    const int tid = tid_, lane = tid & 63, wave = tid >> 6, fr = lane & 15, fq = lane >> 4;
    const bf16_t* Z = (const bf16_t*)(p.ws + WS_Z); bf16_t* Y = (bf16_t*)(p.ws + WS_Y);
    constexpr int NA = M / 64, NB = (M / 128) * 4;
    ItemFeed feed; feed.init(ctr, (volatile LAS int*)(lds + 131072 + 128), part ? 48 : 768, bfirst);
    for (; feed.have(); feed.advance()) {
        feed.prefetch();
        const int j = feed.cur;
        const int it = part ? (j < 16 ? 256 + j : NA + 512 + (j - 16)) : (j < 256 ? NA + 2 * j : (j < 512 ? NA + 2 * (j - 256) + 1 : j - 512));
        int tq_ = tid_; asm volatile("" : "+v"(tq_)); const int tid = tq_, lane = tid & 63, wave = tid >> 6, fr = lane & 15, fq = lane >> 4;
        if (it < NA) {
            const int m0 = it * 64 + wave * 8, c0 = lane * 8; const bool samp = m0 >= MP;
            float s1[8], s2[8], w0[8], w1[8], w2[8];
            { const float* cw = p.conv_a_w + (size_t)li * 3 * BR + c0;
#pragma unroll
              for (int e = 0; e < 8; ++e) { w0[e] = cw[e]; w1[e] = cw[BR + e]; w2[e] = cw[2 * BR + e]; } }
            if (samp) { const int b = (m0 - MP) >> 3; const float* h = p.st_a + ((size_t)(li * NSB + b) * 2) * BR + c0;
#pragma unroll
                for (int e = 0; e < 8; ++e) { s2[e] = h[e]; s1[e] = h[BR + e]; } }
            else if ((m0 & (SEQ - 1)) == 0) {
#pragma unroll
                for (int e = 0; e < 8; ++e) { s2[e] = 0.f; s1[e] = 0.f; } }
            else {
                unpack8(*(const u32x4*)(Z + (size_t)(m0 - 2) * NZ + c0), s2); unpack8(*(const u32x4*)(Z + (size_t)(m0 - 1) * NZ + c0), s1);
            }
#pragma unroll
            for (int r = 0; r < 8; ++r) {
                const bf16_t* zr = Z + (size_t)(m0 + r) * NZ + c0;
                float s0[8], bs[8], y[8];
                unpack8(*(const u32x4*)(zr), s0); unpack8(*(const u32x4*)(zr + BR), bs);
#pragma unroll
                for (int e = 0; e < 8; ++e) { const float cv = w0[e] * s2[e] + w1[e] * s1[e] + w2[e] * s0[e]; y[e] = bs[e] * cv; s2[e] = s1[e]; s1[e] = s0[e]; }
                *(u32x4*)(Y + (size_t)(m0 + r) * D + c0) = pack8(y);
                if (r >= 6 && (samp || (m0 & (SEQ - 1)) == SEQ - 8)) {
                    float* so = samp ? p.out + O_CAS + ((size_t)(li * NSB + ((m0 - MP) >> 3)) * 2 + (r - 6)) * BR + c0 : p.out + O_CAP + ((size_t)(li * 8 + (m0 >> 11)) * 2 + (r - 6)) * BR + c0;
                    *(f32x4*)so = (f32x4){s1[0], s1[1], s1[2], s1[3]}; *(f32x4*)(so + 4) = (f32x4){s1[4], s1[5], s1[6], s1[7]}; }
            }
        } else {
            const int q = it - NA, rb = q >> 2, g = ((q & 3) + (q >> 8)) & 3, m0 = rb * 128; const bool samp = m0 >= MP;
            LAS bf16_t* dT = (LAS bf16_t*)lds;
            const bf16_t* pw = (const bf16_t*)(p.ws + WS_PWT) + (size_t)(li * 4 + g) * 128 * 128;
            LAS bf16_t* pwl = dT + 128 * LDP;
            u32x4 pwr[4];
#pragma unroll
            for (int k = 0; k < 4; ++k) { const int idx = tid + NT * k; pwr[k] = *(const u32x4*)(pw + (idx >> 4) * 128 + (idx & 15) * 8); }
            switch (g) { case 0: pool_d_tile<2>(p, li, g, m0, samp, tid, dT); break; case 1: pool_d_tile<4>(p, li, g, m0, samp, tid, dT); break;
                         case 2: pool_d_tile<8>(p, li, g, m0, samp, tid, dT); break; default: pool_d_tile<16>(p, li, g, m0, samp, tid, dT); break; }
            const int m = m0 + 16 * wave + fr;
            u32x4 gbr[4];
#pragma unroll
            for (int t = 0; t < 4; ++t) gbr[t] = *(const u32x4*)(Z + (size_t)m * NZ + 1536 + g * 128 + 32 * fq + 8 * t);
            if (samp) __syncthreads();
#pragma unroll
            for (int k = 0; k < 4; ++k) { const int idx = tid + NT * k, C = idx >> 4; *(LAS u32x4*)(pwl + (16 * ((C >> 2) & 7) + 4 * (C >> 5) + (C & 3)) * LDP + (idx & 15) * 8) = pwr[k]; }
            __syncthreads();
            f32x4 acc[8];
#pragma unroll
            for (int n = 0; n < 8; ++n) acc[n] = (f32x4){0.f, 0.f, 0.f, 0.f};
#pragma unroll
            for (int ks = 0; ks < 4; ++ks) {
                const bf16x8 af = *(const LAS bf16x8*)(dT + (16 * wave + fr) * LDP + 32 * ks + 8 * fq);
#pragma unroll
                for (int n = 0; n < 8; ++n) { const bf16x8 bf = *(const LAS bf16x8*)(pwl + (16 * n + fr) * LDP + 32 * ks + 8 * fq);
                    acc[n] = __builtin_amdgcn_mfma_f32_16x16x32_bf16(bf, af, acc[n], 0, 0, 0); }
            }
#pragma unroll
            for (int t = 0; t < 4; ++t) { float gb[8]; unpack8(gbr[t], gb);
                u32x4 o; o.x = pk2(acc[2 * t][0] * gb[0], acc[2 * t][1] * gb[1]); o.y = pk2(acc[2 * t][2] * gb[2], acc[2 * t][3] * gb[3]);
                o.z = pk2(acc[2 * t + 1][0] * gb[4], acc[2 * t + 1][1] * gb[5]); o.w = pk2(acc[2 * t + 1][2] * gb[6], acc[2 * t + 1][3] * gb[7]);
                *(u32x4*)(Y + (size_t)m * D + BR + g * 128 + 32 * fq + 8 * t) = o; }
            __syncthreads();
        }
    }
}

template <int R, bool SAMP>
__device__ __forceinline__ void conv_item(const Params& p, int li, int idx, LAS unsigned char* lds, const f32x2 (&w2)[31], const f32x2 bias2) {
    int tid_ = threadIdx.x; asm volatile("" : "+v"(tid_));
    const int tid = tid_, lane = tid & 63, wave = tid >> 6, c = tid;
    const bf16_t* Z = (const bf16_t*)(p.ws + WS_Z); bf16_t* Y = (bf16_t*)(p.ws + WS_Y);
    const int m0 = SAMP ? MP + idx * DSEQ : idx * R;
    const int t0 = SAMP ? 0 : (m0 & (SEQ - 1));
    constexpr int NR = R + 30, NIT = (NR * 64 + NT - 1) / NT;
    LAS float* gl = (LAS float*)lds;
    LAS float* st = (LAS float*)(lds + NR * BR * 4);
    u32x4 ra[NIT], rb[NIT];
#pragma unroll
    for (int k = 0; k < NIT; ++k) { const int i2 = tid + NT * k, row = i2 >> 6, cg = i2 & 63, t = t0 - 30 + row;
        ra[k] = (u32x4){0u, 0u, 0u, 0u}; rb[k] = (u32x4){0u, 0u, 0u, 0u};
        if (i2 < NR * 64) {
            if (SAMP && row < 30) { const float* h = p.st_d + ((size_t)(li * NSB + idx) * 30 + row) * BR + cg * 8; ra[k] = *(const u32x4*)h; rb[k] = *(const u32x4*)(h + 4); }
            else if (t >= 0) ra[k] = *(const u32x4*)(Z + (size_t)(m0 - 30 + row) * NZ + 1024 + cg * 8); } }
#pragma unroll
    for (int k = 0; k < NIT; ++k) { const int i2 = tid + NT * k, row = i2 >> 6, cg = i2 & 63, t = t0 - 30 + row;
        if (i2 < NR * 64) { f32x4 g0, g1;
            if (SAMP && row < 30) { g0 = __builtin_bit_cast(f32x4, ra[k]); g1 = __builtin_bit_cast(f32x4, rb[k]); }
            else { float av[8]; unpack8(ra[k], av);
                g0 = (f32x4){av[0], av[1], av[2], av[3]}; g1 = (f32x4){av[4], av[5], av[6], av[7]};
                if (SAMP) { float* so = p.out + O_CDS + ((size_t)(li * NSB + idx) * 30 + (row - 8)) * BR + cg * 8; *(f32x4*)so = g0; *(f32x4*)(so + 4) = g1; }
                else if (row >= 32 && t0 == SEQ - 32) { float* so = p.out + O_CDP + ((size_t)(li * 8 + (m0 >> 11)) * 30 + (row - 32)) * BR + cg * 8; *(f32x4*)so = g0; *(f32x4*)(so + 4) = g1; } }
            *(LAS f32x4*)(gl + row * BR + cg * 8) = g0; *(LAS f32x4*)(gl + row * BR + cg * 8 + 4) = g1; } }
    constexpr int RH = R / 2;
    const int c2 = (tid & 255) * 2, rbase = (tid >> 8) * RH;
    const int cgf = tid & 63;
    const f32x4 lg0 = *(const f32x4*)(p.cln_g + li * BR + cgf * 8), lg1 = *(const f32x4*)(p.cln_g + li * BR + cgf * 8 + 4);
    const f32x4 lb0 = *(const f32x4*)(p.cln_b + li * BR + cgf * 8), lb1 = *(const f32x4*)(p.cln_b + li * BR + cgf * 8 + 4);
    u32x4 gdr[R * 64 / NT];
#pragma unroll
    for (int k = 0; k < R * 64 / NT; ++k) gdr[k] = *(const u32x4*)(Z + (size_t)(m0 + ((tid + NT * k) >> 6)) * NZ + 1536 + cgf * 8);
    __syncthreads();
    f32x2 y2[RH];
#pragma unroll
    for (int o4 = 0; o4 < RH / 4; ++o4) { f32x2 g2[34];
#pragma unroll
        for (int i = 0; i < 34; ++i) g2[i] = *(const LAS f32x2*)(gl + (rbase + 4 * o4 + i) * BR + c2);
#pragma unroll
        for (int q = 0; q < 4; ++q) { f32x2 acc = bias2;
#pragma unroll
            for (int j = 0; j < 31; ++j) acc += w2[j] * g2[q + j];
            y2[4 * o4 + q] = acc; } }
    __syncthreads();
#pragma unroll
    for (int o = 0; o < RH; ++o) *(LAS f32x2*)(gl + (rbase + o) * BR + c2) = y2[o];
    __syncthreads();
    for (int o = wave; o < R; o += NWAVES) {
        float v[8]; float sm = 0.f;
#pragma unroll
        for (int k = 0; k < 8; ++k) { v[k] = gl[o * BR + lane + 64 * k]; sm += v[k]; }
        const float mean = wave_sum(sm) * (1.f / BR); float qv = 0.f;
#pragma unroll
        for (int k = 0; k < 8; ++k) { const float dd = v[k] - mean; qv += dd * dd; }
        const float rs = rsqrtf(wave_sum(qv) * (1.f / BR) + EPS);
        if (lane == 0) { st[2 * o] = mean; st[2 * o + 1] = rs; }
    }
    __syncthreads();
#pragma unroll
    for (int k = 0; k < R * 64 / NT; ++k) { const int i2 = tid + NT * k, o = i2 >> 6, cg = i2 & 63;
        const f32x4 y0 = *(const LAS f32x4*)(gl + o * BR + cg * 8), y1 = *(const LAS f32x4*)(gl + o * BR + cg * 8 + 4);
        const float mean = st[2 * o], rs = st[2 * o + 1];
        float gd[8], ov[8]; unpack8(gdr[k], gd);
#pragma unroll
        for (int e = 0; e < 4; ++e) { ov[e] = siluf_((y0[e] - mean) * rs * lg0[e] + lb0[e]) * gd[e]; ov[4 + e] = siluf_((y1[e] - mean) * rs * lg1[e] + lb1[e]) * gd[4 + e]; }
        *(u32x4*)(Y + (size_t)(m0 + o) * D + BR + cg * 8) = pack8(ov); }
    __syncthreads();
}

__device__ __forceinline__ void mixer_odd(const Params& p, int li, LAS unsigned char* lds, int part, int bfirst, unsigned* ctr) {
    int tid_ = threadIdx.x; asm volatile("" : "+v"(tid_));
    const int tid = tid_, lane = tid & 63, wave = tid >> 6, fr = lane & 15, fq = lane >> 4;
    const bf16_t* Z = (const bf16_t*)(p.ws + WS_Z); bf16_t* Y = (bf16_t*)(p.ws + WS_Y);
    constexpr int NC = (M / 128) * 4, NDP = MP / 32, NDS = NSB;
    f32x2 cw2[31]; f32x2 cb2;
    { const int c2 = (tid_ & 255) * 2;
#pragma unroll
      for (int j = 0; j < 31; ++j) cw2[j] = *(const f32x2*)(p.dw_w + ((size_t)li * 31 + j) * BR + c2);
      cb2 = *(const f32x2*)(p.dw_b + li * BR + c2); }
    ItemFeed feed; feed.init(ctr, (volatile LAS int*)(lds + 131072 + 128), part ? 160 : 1024, bfirst);
    for (; feed.have(); feed.advance()) {
        feed.prefetch();
        const int j = feed.cur;
        const int it = part ? (j < 32 ? 512 + j : NC + NDP + (j - 32)) : (j < 512 ? NC + j : j - 512);
        int tq_ = tid_; asm volatile("" : "+v"(tq_)); const int tid = tq_, lane = tid & 63, wave = tid >> 6, fr = lane & 15, fq = lane >> 4;
        if (it < NC) {
            const int rb = it >> 2, g = ((it & 3) + (it >> 8)) & 3, m0 = rb * 128; const bool samp = m0 >= MP;
            LAS bf16_t* Al = (LAS bf16_t*)lds;
            LAS bf16_t* vT = (LAS bf16_t*)(lds + 128 * LDP * 2);
            const float* stat = (const float*)(p.ws + WS_STAT) + ((size_t)li * M + m0) * 2;
            const bf16_t* sw = (const bf16_t*)(p.ws + WS_SGW) + (size_t)(li * 4 + g) * 128 * 128;
            const int ks_hi = wave >> 1, ks_lo = samp ? ks_hi : 0;
            bf16x8 wfr[4];
#pragma unroll
            for (int ks = 0; ks < 4; ++ks) { wfr[ks] = (bf16x8){0, 0, 0, 0, 0, 0, 0, 0};
                if (ks >= ks_lo && ks <= ks_hi) { if (!samp) wfr[ks] = *(const bf16x8*)(sw + (16 * wave + fr) * 128 + 32 * ks + 8 * fq);
                    else if (((16 * wave + fr) >> 3) == 4 * ks + fq) wfr[ks] = *(const bf16x8*)(sw + (fr & 7) * 128); } }
            const int m = m0 + 16 * wave + fr;
            u32x4 ur[4];
#pragma unroll
            for (int t = 0; t < 4; ++t) ur[t] = *(const u32x4*)(Z + (size_t)m * NZ + g * 128 + 32 * fq + 8 * t);
            { const int pc = tid >> 5, ch = g * 128 + pc * 8, j0 = tid & 31;
              const f32x4 lg0 = *(const f32x4*)(p.sgu_ln_g + li * BR + ch), lg1 = *(const f32x4*)(p.sgu_ln_g + li * BR + ch + 4);
              const f32x4 lb0 = *(const f32x4*)(p.sgu_ln_b + li * BR + ch), lb1 = *(const f32x4*)(p.sgu_ln_b + li * BR + ch + 4);
              u32x4 vr[4]; f32x2 sq2[4];
#pragma unroll
              for (int k = 0; k < 4; ++k) { const int j = j0 + 32 * k; vr[k] = *(const u32x4*)(Z + (size_t)(m0 + j) * NZ + BR + ch); sq2[k] = *(const f32x2*)(stat + 2 * j); }
#pragma unroll
              for (int k = 0; k < 4; ++k) { const int j = j0 + 32 * k; float v[8]; unpack8(vr[k], v);
                const float mu = sq2[k].x * (1.f / BR), rs = rsqrtf(fmaxf(sq2[k].y * (1.f / BR) - mu * mu, 0.f) + EPS);
#pragma unroll
                for (int e = 0; e < 4; ++e) { v[e] = (v[e] - mu) * rs * lg0[e] + lb0[e]; v[4 + e] = (v[4 + e] - mu) * rs * lg1[e] + lb1[e]; }
#pragma unroll
                for (int e = 0; e < 8; ++e) vT[(16 * ((2 * pc + (e >> 2)) & 7) + 4 * (pc >> 2) + (e & 3)) * LDP + j] = (bf16_t)f2bf(v[e]);
                if (samp) { float* so = p.out + O_CV + ((size_t)li * MS + (m0 - MP) + j) * BR + ch; *(f32x4*)so = (f32x4){v[0], v[1], v[2], v[3]}; *(f32x4*)(so + 4) = (f32x4){v[4], v[5], v[6], v[7]}; } } }
            __syncthreads();
            f32x4 acc[8];
#pragma unroll
            for (int n = 0; n < 8; ++n) acc[n] = (f32x4){0.f, 0.f, 0.f, 0.f};
#pragma unroll
            for (int ks = 0; ks < 4; ++ks) { if (ks < ks_lo || ks > ks_hi) continue;
                const bf16x8 wf = wfr[ks];
#pragma unroll
                for (int n = 0; n < 8; ++n) { const bf16x8 vf = *(const LAS bf16x8*)(vT + (16 * n + fr) * LDP + 32 * ks + 8 * fq);
                    acc[n] = __builtin_amdgcn_mfma_f32_16x16x32_bf16(vf, wf, acc[n], 0, 0, 0); }
            }
            const int pos = samp ? (m & 7) : (m & 127);
            const float bias = p.sgu_b[(size_t)(li * 4 + g) * 128 + pos];
#pragma unroll
            for (int t = 0; t < 4; ++t) { float u[8]; unpack8(ur[t], u);
                u32x4 o; o.x = pk2(u[0] * (acc[2 * t][0] + bias), u[1] * (acc[2 * t][1] + bias)); o.y = pk2(u[2] * (acc[2 * t][2] + bias), u[3] * (acc[2 * t][3] + bias));
                o.z = pk2(u[4] * (acc[2 * t + 1][0] + bias), u[5] * (acc[2 * t + 1][1] + bias)); o.w = pk2(u[6] * (acc[2 * t + 1][2] + bias), u[7] * (acc[2 * t + 1][3] + bias));
                *(u32x4*)(Y + (size_t)m * D + g * 128 + 32 * fq + 8 * t) = o; }
            __syncthreads();
        } else if (it < NC + NDP) conv_item<32, false>(p, li, it - NC, lds, cw2, cb2);
        else conv_item<8, true>(p, li, it - NC - NDP, lds, cw2, cb2);
    }
}

#define XB_TMO      128
#define XB_XCNT(j)  (256  + 64 * (j))
#define XB_XSUB(j)  (1280 + 64 * (j))
#define XB_XGEN(j)  (2304 + 64 * (j))
#define XB_TOP      3328
#define XB_TOPGEN   3392
#define XCD_BAR_WORDS 3456
#define XB_SPIN_CAP (1u << 18)
__device__ __forceinline__ unsigned xb_ld(unsigned* p)              { return __hip_atomic_load(p, __ATOMIC_RELAXED, __HIP_MEMORY_SCOPE_AGENT); }
__device__ __forceinline__ unsigned xb_add(unsigned* p, unsigned v) { return __hip_atomic_fetch_add(p, v, __ATOMIC_RELAXED, __HIP_MEMORY_SCOPE_AGENT); }
__device__ __forceinline__ unsigned xb_xcc_id() { return (unsigned)__builtin_amdgcn_s_getreg((3 << 11) | 20) & 0xFu; }
#define XB_SPIN(cond, bar) do { unsigned _sp = 0; while (cond) { __builtin_amdgcn_s_sleep(1); \
    if ((++_sp & 255u) == 0u) { if (xb_ld(&(bar)[XB_TMO])) break; if (_sp > XB_SPIN_CAP) { atomicAdd(&(bar)[XB_TMO], 1u); break; } } } } while (0)
struct XcdBarrier { unsigned* bar; unsigned x; volatile LAS unsigned* st; };
__device__ __forceinline__ XcdBarrier xcd_barrier_post(unsigned* bar, volatile LAS unsigned* st) {
    XcdBarrier b; b.bar = bar; b.x = xb_xcc_id(); b.st = st;
    if (threadIdx.x == 0) (void)xb_add(&bar[XB_XCNT(b.x)], 1u);
    return b;
}
__device__ __forceinline__ void xcd_barrier_complete(unsigned* bar, unsigned x, unsigned& nloc, unsigned& nx) {
    const unsigned G = gridDim.x * gridDim.y * gridDim.z;
    unsigned sum, cnt, mine, sp = 0u;
    for (;;) {
        sum = 0u; cnt = 0u; mine = 0u;
#pragma unroll
        for (unsigned j = 0; j < 16; ++j) { const unsigned c = xb_ld(&bar[XB_XCNT(j)]); sum += c; cnt += (c > 0u) ? 1u : 0u; mine = (j == x) ? c : mine; }
        if (sum == G) break;
        __builtin_amdgcn_s_sleep(1);
        if ((++sp & 255u) == 0u) { if (xb_ld(&bar[XB_TMO])) break; if (sp > XB_SPIN_CAP) { atomicAdd(&bar[XB_TMO], 1u); break; } }
    }
    nloc = mine > 0u ? mine : 1u; nx = cnt > 0u ? cnt : 1u;
}
__device__ __forceinline__ void xcd_barrier(const XcdBarrier& b) {
    asm volatile("s_waitcnt vmcnt(0)" ::: "memory");
    __syncthreads();
    if (threadIdx.x == 0) {
        unsigned* bar = b.bar; const unsigned bx = xb_xcc_id();
        __builtin_amdgcn_s_waitcnt(0);
        unsigned nloc = b.st[0], nx = b.st[1];
        if (nloc == 0u) { xcd_barrier_complete(bar, bx, nloc, nx); b.st[0] = nloc; b.st[1] = nx; }
        const unsigned old = xb_add(&bar[XB_XSUB(bx)], 1u);
        const unsigned gen = old / nloc;
        if (old + 1u == (gen + 1u) * nloc) {
            __builtin_amdgcn_fence(__ATOMIC_RELEASE, "agent");
            asm volatile("s_waitcnt vmcnt(0)" ::: "memory");
            const unsigned og = xb_add(&bar[XB_TOP], 1u);
            const unsigned tg = og / nx;
            if (og + 1u == (tg + 1u) * nx) xb_add(&bar[XB_TOPGEN], 1u);
            else XB_SPIN(xb_ld(&bar[XB_TOPGEN]) == tg, bar);
            __builtin_amdgcn_fence(__ATOMIC_ACQUIRE, "agent");
            xb_add(&bar[XB_XGEN(bx)], 1u);
            asm volatile("s_waitcnt vmcnt(0)" ::: "memory");
        } else {
            XB_SPIN(xb_ld(&bar[XB_XGEN(bx)]) == gen, bar);
            __builtin_amdgcn_fence(__ATOMIC_ACQUIRE, "agent");
            asm volatile("s_waitcnt vmcnt(0)" ::: "memory");
        }
    }
    __syncthreads();
}

__global__ void __launch_bounds__(NT, 2) fwd_megakernel(Params p) {
    extern __shared__ __attribute__((aligned(16))) unsigned char lds_raw[];
    LAS unsigned char* lds = (LAS unsigned char*)lds_raw;
    cg::grid_group grid = cg::this_grid();
    if (p.ph_hi > 1000) grid.sync();
    for (int u = threadIdx.x; u < 64; u += NT) ((LAS unsigned*)(lds + 131072))[u] = 0u;
    __syncthreads();
    XcdBarrier bar = xcd_barrier_post((unsigned*)p.ws, (volatile LAS unsigned*)(lds + 131072) + 8);
    weights_phase(p, lds, 0, 0);
    prologue(p, lds);
    xcd_barrier(bar);
    const int bf_g1 = gridDim.x >= 128 ? 48 : 0, bf_g2 = gridDim.x >= 128 ? 32 : 0;
#pragma unroll 1
    for (int ph = 0; ph <= 16; ++ph) {
        const int kind = ph & 3, l = ph >> 2;
        if (ph < 16) {
            const bool sp = (kind & 1) != 0, inproj = kind < 2; const int r0 = sp ? MP : 0, nr = sp ? MS : MP, N = inproj ? NIN : D;
            const bf16_t* A = (const bf16_t*)(p.ws + (inproj ? WS_XB : WS_Y)) + (size_t)r0 * D;
            const bf16_t* Bt = inproj ? (const bf16_t*)(p.ws + WS_WIN) + (size_t)l * NIN * D : (const bf16_t*)(p.ws + WS_WOUT) + (size_t)l * D * D;
            bf16_t* C = inproj ? (bf16_t*)(p.ws + WS_Z) + (size_t)r0 * NZ : (bf16_t*)(p.ws + (sp ? WS_OS : WS_Z));
            const bool ksplit = kind == 3;
            pg8::Gemm g{A, Bt, nr, N, ksplit ? D / 2 : D, D};
            pg8::StaticOrder S; S.init(nr, N, gridDim.x, blockIdx.x, ksplit ? D : 0);
            pg8::EpiZ E{C, inproj ? NZ : D, inproj ? (const float*)(p.ws + WS_RSTD) + r0 : nullptr, (inproj && (l & 1)) ? (float*)(p.ws + WS_STAT) + ((size_t)(l >> 1) * M + r0) * 2 : nullptr, inproj ? ((l & 1) ? 2 : 1) : 0, (size_t)MS * D};
            pg8::gemm_phase<pg8::EpiZ, pg8::StaticOrder, true, true>(lds, g, S, E);
        }
        if (kind == 1 || kind == 2) { const int part = kind == 2 ? 1 : 0; unsigned* ctr = part ? nullptr : (unsigned*)p.ws + 3584 + 64 * l;
            if (l & 1) mixer_odd(p, l >> 1, lds, part, 0, ctr); else mixer_even(p, l >> 1, lds, part, 0, ctr); }
        if ((kind == 0 && l > 0) || kind == 3) { const bool pr = kind == 3; post_phase(p, pr ? l : l - 1, pr ? 0 : MP, pr ? MP : M, pr ? bf_g2 : 0); }
        if (kind == 2 && l < 3) weights_phase(p, lds, l + 1, gridDim.x >= 256 ? ((l & 1) ? 160 : 48) : 0);
        if (ph < 16) xcd_barrier(bar);
    }
}

extern "C" void kernel_launch(void* const* d_in, const int* in_sizes, int n_in, void* d_out, int out_size, void* d_ws, size_t ws_size, hipStream_t stream) {
    static int grid = 0;
    if (grid == 0) {
        if (n_in != 22 || (size_t)out_size != O_END || ws_size < WS_END) { fprintf(stderr, "kernel_launch: unexpected shapes (n_in %d out %d ws %zu)\n", n_in, out_size, ws_size); grid = -1; return; }
        int dev = 0, cus = 0, per_cu = 0;
        hipGetDevice(&dev); hipDeviceGetAttribute(&cus, hipDeviceAttributeMultiprocessorCount, dev);
        if (hipFuncSetAttribute((const void*)fwd_megakernel, hipFuncAttributeMaxDynamicSharedMemorySize, LDS_BYTES) != hipSuccess) { fprintf(stderr, "kernel_launch: hipFuncSetAttribute failed\n"); grid = -1; return; }
        if (hipOccupancyMaxActiveBlocksPerMultiprocessor(&per_cu, (const void*)fwd_megakernel, NT, LDS_BYTES) != hipSuccess || per_cu < 1) { fprintf(stderr, "kernel_launch: occupancy query says %d\n", per_cu); per_cu = 1; }
        (void)hipGetLastError();
        grid = cus * (per_cu > 1 ? 1 : per_cu);
    }
    if (grid < 0) return;
    if (hipMemsetAsync(d_ws, 0, 16384, stream) != hipSuccess) { fprintf(stderr, "kernel_launch: memset failed\n"); return; }
    Params p{};
    const float** f = (const float**)&p;
    for (int i = 0; i < 22; ++i) f[i] = (const float*)d_in[i];
    p.out = (float*)d_out; p.ws = (unsigned char*)d_ws;
    p.ph_lo = 0; p.ph_hi = 17;
    void* args[] = {&p};
    hipError_t e = hipLaunchCooperativeKernel((const void*)fwd_megakernel, dim3(grid), dim3(NT), args, LDS_BYTES, stream);
    if (e != hipSuccess) fprintf(stderr, "cooperative launch failed: %s (grid %d)\n", hipGetErrorString(e), grid);
}
```
